# Optimizing an MI355X kernel written in HIP

```python
import math
import jax, jax.numpy as jnp
from jax import lax
import numpy as np

D_MODEL = 2048
BATCH = 2
SEQ = 4096
DEPTH = 2

GRID_W = 64
ROPE_THETA = 500000.0
Q_BLOCK = 128

MLA_HEADS = 8
MLA_Q_RANK = 512
MLA_KV_RANK = 256
MLA_NOPE = 128
MLA_ROPE = 64
MLA_V = 128

NA_HEADS = 4
NA_DIM = 128
NA_WIN_H = 8
NA_WIN_W = 16

DIFF_HEADS = 4
DIFF_QK = 64
DIFF_V = 2 * DIFF_QK
DIFF_ROT = DIFF_QK // 4

MIX_A = MLA_HEADS * MLA_V
MIX_B = NA_HEADS * NA_DIM
MIX_C = DIFF_HEADS * DIFF_V
MIX_WIDTH = MIX_A + MIX_B + MIX_C

IN_A = MLA_Q_RANK + MLA_KV_RANK + MLA_ROPE
IN_B = 3 * NA_HEADS * NA_DIM
IN_C = 2 * DIFF_HEADS * 2 * DIFF_QK + DIFF_HEADS * DIFF_V
IN_WIDTH = IN_A + IN_B + IN_C

N_EXPERTS = 64
TOP_K = 8
N_GROUPS = 8
TOPK_GROUPS = 4
EXPERT_FF = 512
SHARED_FF = 512
ROUTED_SCALE = 2.5

DN_ALPHA = (2 * DEPTH) ** 0.25
DN_BETA = (8 * DEPTH) ** -0.25
LN_EPS = 1e-5
RMS_EPS = 1e-6

kernel_name = "hybrid_mla_natten_diff_moe_encoder"


def _layernorm(x, g=None, b=None):
    xf = x.astype(jnp.float32)
    mu = jnp.mean(xf, -1, keepdims=True)
    var = jnp.mean(jnp.square(xf - mu), -1, keepdims=True)
    y = (xf - mu) * lax.rsqrt(var + LN_EPS)
    if g is not None:
        y = y * g.astype(jnp.float32) + b.astype(jnp.float32)
    return y.astype(x.dtype)


def _rmsnorm(x, g):
    xf = x.astype(jnp.float32)
    y = xf * lax.rsqrt(jnp.mean(jnp.square(xf), -1, keepdims=True) + RMS_EPS)
    return (y * g.astype(jnp.float32)).astype(x.dtype)


def _rope(x, pos, rot_dim):
    half = rot_dim // 2
    inv = ROPE_THETA ** (-jnp.arange(half, dtype=jnp.float32) / half)
    ang = pos.astype(jnp.float32)[:, None] * inv[None, :]
    shape = (ang.shape[0],) + (1,) * (x.ndim - 3) + (half,)
    cos = jnp.cos(ang).reshape(shape)
    sin = jnp.sin(ang).reshape(shape)
    xr = x[..., :rot_dim].astype(jnp.float32)
    x1, x2 = xr[..., :half], xr[..., half:]
    rot = jnp.concatenate([x1 * cos - x2 * sin, x2 * cos + x1 * sin], -1).astype(x.dtype)
    return jnp.concatenate([rot, x[..., rot_dim:]], -1)


def _sweep_query_blocks(fn, *qs):
    b, s = qs[0].shape[:2]
    nblk = s // Q_BLOCK
    blk = tuple(jnp.moveaxis(q.reshape((b, nblk, Q_BLOCK) + q.shape[2:]), 1, 0) for q in qs)
    out = lax.map(lambda args: fn(*args), blk)
    return jnp.moveaxis(out, 0, 1).reshape((b, s) + out.shape[3:])


def _mla(u, pos, q_norm, w_uq, kv_norm, w_ukv):
    b, s, _ = u.shape
    cq, ckv, kr = jnp.split(u, [MLA_Q_RANK, MLA_Q_RANK + MLA_KV_RANK], -1)
    q = (_rmsnorm(cq, q_norm) @ w_uq).reshape(b, s, MLA_HEADS, MLA_NOPE + MLA_ROPE)
    q_nope = q[..., :MLA_NOPE]
    q_rope = _rope(q[..., MLA_NOPE:], pos, MLA_ROPE)
    kv = (_rmsnorm(ckv, kv_norm) @ w_ukv).reshape(b, s, MLA_HEADS, MLA_NOPE + MLA_V)
    k_nope, v = kv[..., :MLA_NOPE], kv[..., MLA_NOPE:]
    k_rope = _rope(kr, pos, MLA_ROPE)
    scale = (MLA_NOPE + MLA_ROPE) ** -0.5

    def block(qn, qr):
        sc = (jnp.einsum('bqhd,bkhd->bhqk', qn, k_nope)
              + jnp.einsum('bqhr,bkr->bhqk', qr, k_rope))
        p = jax.nn.softmax(sc.astype(jnp.float32) * scale, axis=-1).astype(v.dtype)
        return jnp.einsum('bhqk,bkhd->bqhd', p, v)

    o = _sweep_query_blocks(block, q_nope, q_rope)
    return o.reshape(b, s, MIX_A)


def _neighbourhood_attn(u, rpb):
    b, s, _ = u.shape
    rows = s // GRID_W
    kh = min(NA_WIN_H, rows)
    q, k, v = jnp.split(u, 3, -1)
    q, k, v = (t.reshape(b, rows, GRID_W, NA_HEADS, NA_DIM) for t in (q, k, v))
    r = jnp.arange(rows)
    r0 = jnp.clip(r - kh // 2, 0, rows - kh)
    key_rows = r0[:, None] + jnp.arange(kh)[None, :]
    k_blk = k[:, key_rows].reshape(b, rows, kh * GRID_W, NA_HEADS, NA_DIM)
    v_blk = v[:, key_rows].reshape(b, rows, kh * GRID_W, NA_HEADS, NA_DIM)
    col = jnp.arange(GRID_W)
    c0 = jnp.clip(col - NA_WIN_W // 2, 0, GRID_W - NA_WIN_W)
    col_in = (col[None, :] >= c0[:, None]) & (col[None, :] < c0[:, None] + NA_WIN_W)
    mask = jnp.broadcast_to(col_in[:, None, :], (GRID_W, kh, GRID_W)).reshape(GRID_W, kh * GRID_W)
    dr = key_rows - r[:, None] + (NA_WIN_H - 1)
    dc = jnp.clip(col[None, :] - col[:, None], -(NA_WIN_W - 1), NA_WIN_W - 1) + (NA_WIN_W - 1)
    bias = rpb[:, dr[:, None, :, None], dc[None, :, None, :]]
    bias = bias.reshape(NA_HEADS, rows, GRID_W, kh * GRID_W).astype(jnp.float32)
    sc = jnp.einsum('brqhd,brkhd->bhrqk', q, k_blk).astype(jnp.float32) * (NA_DIM ** -0.5) + bias
    sc = jnp.where(mask, sc, -jnp.inf)
    p = jax.nn.softmax(sc, axis=-1).astype(v.dtype)
    o = jnp.einsum('bhrqk,brkhd->brqhd', p, v_blk)
    return o.reshape(b, s, MIX_B)


def _diff_attn(u, pos, lq1, lk1, lq2, lk2, subln, lam_init):
    b, s, _ = u.shape
    nq = DIFF_HEADS * 2 * DIFF_QK
    q, k, v = jnp.split(u, [nq, 2 * nq], -1)
    q = _rope(q.reshape(b, s, DIFF_HEADS, 2, DIFF_QK), pos, DIFF_ROT)
    k = _rope(k.reshape(b, s, DIFF_HEADS, 2, DIFF_QK), pos, DIFF_ROT)
    v = v.reshape(b, s, DIFF_HEADS, DIFF_V)
    lam = (jnp.exp(jnp.sum(lq1.astype(jnp.float32) * lk1.astype(jnp.float32)))
           - jnp.exp(jnp.sum(lq2.astype(jnp.float32) * lk2.astype(jnp.float32))) + lam_init)
    k1, k2 = k[..., 0, :], k[..., 1, :]
    scale = DIFF_QK ** -0.5

    def block(q1, q2):
        a1 = jax.nn.softmax(jnp.einsum('bqhd,bkhd->bhqk', q1, k1).astype(jnp.float32) * scale, axis=-1)
        a2 = jax.nn.softmax(jnp.einsum('bqhd,bkhd->bhqk', q2, k2).astype(jnp.float32) * scale, axis=-1)
        return jnp.einsum('bhqk,bkhd->bqhd', (a1 - lam * a2).astype(v.dtype), v)

    o = _sweep_query_blocks(block, q[..., 0, :], q[..., 1, :])
    o = _rmsnorm(o, subln) * (1.0 - lam_init)
    return o.reshape(b, s, MIX_C)


def _moe(h, router_w, router_bias, w_gate, w_up, w_down, sh_gate, sh_up, sh_down):
    b, s, d = h.shape
    t = h.reshape(b * s, d)
    scores = jax.nn.sigmoid((t @ router_w).astype(jnp.float32))
    biased = scores + router_bias.astype(jnp.float32)
    grp = biased.reshape(-1, N_GROUPS, N_EXPERTS // N_GROUPS)
    grp_score = jnp.sum(lax.top_k(grp, 2)[0], -1)
    _, gidx = lax.top_k(grp_score, TOPK_GROUPS)
    gmask = jnp.sum(jax.nn.one_hot(gidx, N_GROUPS, dtype=jnp.float32), 1) > 0
    emask = jnp.repeat(gmask, N_EXPERTS // N_GROUPS, axis=1)
    _, eidx = lax.top_k(jnp.where(emask, biased, -jnp.inf), TOP_K)
    w = jnp.take_along_axis(scores, eidx, -1)
    w = w / jnp.sum(w, -1, keepdims=True) * ROUTED_SCALE
    gates = jnp.sum(jax.nn.one_hot(eidx, N_EXPERTS, dtype=jnp.float32) * w[..., None], 1)

    def expert(acc, xs):
        wg, wu, wd, g = xs
        y = (jax.nn.silu(t @ wg) * (t @ wu)) @ wd
        return acc + g[:, None] * y.astype(jnp.float32), None

    routed, _ = lax.scan(expert, jnp.zeros(t.shape, jnp.float32), (w_gate, w_up, w_down, gates.T))
    shared = (jax.nn.silu(t @ sh_gate) * (t @ sh_up)) @ sh_down
    return (routed.astype(t.dtype) + shared).reshape(b, s, d)


def setup_inputs(seed: int = 0) -> dict:
    key = jax.random.key(seed)
    ks = jax.random.split(key, 28)
    L, D, E, F, FS = DEPTH, D_MODEL, N_EXPERTS, EXPERT_FF, SHARED_FF

    def nrm(i, shape, scale):
        return scale * jax.random.normal(ks[i], shape, jnp.float32)

    return {
        "x": nrm(0, (BATCH, SEQ, D), 1.0),
        "c": nrm(1, (BATCH, D), 1.0),
        "w_ada": nrm(2, (L, D, 6 * D), 0.1 * D ** -0.5),
        "b_ada": nrm(3, (L, 6 * D), 0.02),
        "w_in": nrm(4, (L, D, IN_WIDTH), D ** -0.5),
        "mla_q_norm": 1.0 + nrm(5, (L, MLA_Q_RANK), 0.1),
        "mla_w_uq": nrm(6, (L, MLA_Q_RANK, MLA_HEADS * (MLA_NOPE + MLA_ROPE)), MLA_Q_RANK ** -0.5),
        "mla_kv_norm": 1.0 + nrm(7, (L, MLA_KV_RANK), 0.1),
        "mla_w_ukv": nrm(8, (L, MLA_KV_RANK, MLA_HEADS * (MLA_NOPE + MLA_V)), MLA_KV_RANK ** -0.5),
        "na_rpb": nrm(9, (L, NA_HEADS, 2 * NA_WIN_H - 1, 2 * NA_WIN_W - 1), 0.2),
        "diff_lq1": nrm(10, (L, DIFF_QK), 0.1),
        "diff_lk1": nrm(11, (L, DIFF_QK), 0.1),
        "diff_lq2": nrm(12, (L, DIFF_QK), 0.1),
        "diff_lk2": nrm(13, (L, DIFF_QK), 0.1),
        "diff_subln": 1.0 + nrm(14, (L, DIFF_V), 0.1),
        "w_o": nrm(15, (L, MIX_WIDTH, D), DN_BETA * MIX_WIDTH ** -0.5),
        "ln1_g": 1.0 + nrm(16, (L, D), 0.1),
        "ln1_b": nrm(17, (L, D), 0.02),
        "router_w": nrm(18, (L, D, E), D ** -0.5),
        "router_bias": nrm(19, (L, E), 0.01),
        "exp_w_gate": nrm(20, (L, E, D, F), D ** -0.5),
        "exp_w_up": nrm(21, (L, E, D, F), D ** -0.5),
        "exp_w_down": nrm(22, (L, E, F, D), DN_BETA * F ** -0.5),
        "sh_w_gate": nrm(23, (L, D, FS), D ** -0.5),
        "sh_w_up": nrm(24, (L, D, FS), D ** -0.5),
        "sh_w_down": nrm(25, (L, FS, D), DN_BETA * FS ** -0.5),
        "ln2_g": 1.0 + nrm(26, (L, D), 0.1),
        "ln2_b": nrm(27, (L, D), 0.02),
    }


def reference(x, c, w_ada, b_ada, w_in, mla_q_norm, mla_w_uq, mla_kv_norm, mla_w_ukv,
              na_rpb, diff_lq1, diff_lk1, diff_lq2, diff_lk2, diff_subln, w_o,
              ln1_g, ln1_b, router_w, router_bias, exp_w_gate, exp_w_up, exp_w_down,
              sh_w_gate, sh_w_up, sh_w_down, ln2_g, ln2_b):
    pos = jnp.arange(x.shape[1], dtype=jnp.int32)
    cond = jax.nn.silu(c)
    for i in range(DEPTH):
        lam_init = 0.8 - 0.6 * math.exp(-0.3 * i)
        ada = cond @ w_ada[i] + b_ada[i]
        sh_a, sc_a, g_a, sh_f, sc_f, g_f = [a[:, None, :] for a in jnp.split(ada, 6, -1)]

        h = _layernorm(x) * (1.0 + sc_a) + sh_a
        u = h @ w_in[i]
        ua, ub, uc = jnp.split(u, [IN_A, IN_A + IN_B], -1)
        mix = jnp.concatenate([
            _mla(ua, pos, mla_q_norm[i], mla_w_uq[i], mla_kv_norm[i], mla_w_ukv[i]),
            _neighbourhood_attn(ub, na_rpb[i]),
            _diff_attn(uc, pos, diff_lq1[i], diff_lk1[i], diff_lq2[i], diff_lk2[i],
                       diff_subln[i], lam_init),
        ], -1)
        x = _layernorm(DN_ALPHA * x + (1.0 + g_a) * (mix @ w_o[i]), ln1_g[i], ln1_b[i])

        h = _layernorm(x) * (1.0 + sc_f) + sh_f
        y = _moe(h, router_w[i], router_bias[i], exp_w_gate[i], exp_w_up[i], exp_w_down[i],
                 sh_w_gate[i], sh_w_up[i], sh_w_down[i])
        x = _layernorm(DN_ALPHA * x + (1.0 + g_f) * y, ln2_g[i], ln2_b[i])
    return x
```

```cpp
#include <hip/hip_runtime.h>
#include <cstdio>
#include <cstdint>

#ifndef MK_PER_PHASE
#define MK_PER_PHASE 0
#endif

#define LAS __attribute__((address_space(3)))
#define GAS __attribute__((address_space(1)))
typedef unsigned short bf16;
typedef short bf16x8 __attribute__((ext_vector_type(8)));
typedef short s16x4 __attribute__((ext_vector_type(4)));
typedef float f32x2 __attribute__((ext_vector_type(2)));
typedef float f32x4 __attribute__((ext_vector_type(4)));
typedef float f32x16 __attribute__((ext_vector_type(16)));
typedef unsigned u32x2 __attribute__((ext_vector_type(2)));
typedef unsigned u32x4 __attribute__((ext_vector_type(4)));

constexpr int NTOK = 8192, SEQ = 4096, DM = 2048, NLAYER = 2;
constexpr int UW = 4096;
constexpr int U_CQ = 0, U_CKV = 512, U_KR = 768, U_NA = 1024, U_DF = 2560;
constexpr int QMW = 1536, KVW = 2048;
constexpr int NEXP = 64, FFE = 512, NE1 = 65;
constexpr int SLOT_MAX = 90112;
constexpr float DN_ALPHA = 1.4142135623730951f;
constexpr float LN_EPS = 1e-5f, RMS_EPS = 1e-6f;
constexpr int ADA_W = 6 * DM;
constexpr float YS_SCALE = 16.f;
#ifndef MOE_FP8_LAST
#ifndef DOWN_LEAD
#define DOWN_LEAD 4
#endif
#ifndef MOE_CHUNK
#define MOE_CHUNK 1
#endif
#define MOE_FP8_LAST 1
#endif
#ifndef MOE_FP8_GU_ALL
#define MOE_FP8_GU_ALL 1
#endif
#ifndef MOE_FP8_DOWN_ALL
#define MOE_FP8_DOWN_ALL 1
#endif
constexpr float W8_SCALE = 64.f, ACT8_SCALE = 4.f;
__device__ __forceinline__ float clamp8(float x) { return __builtin_amdgcn_fmed3f(x, -448.f, 448.f); }

constexpr size_t MiB = 1u << 20;
constexpr size_t WS_CTL = 0, CTL_ZERO_BYTES = 1 * MiB;
constexpr size_t WS_ADA = 1 * MiB;
constexpr size_t WS_ROPEM = 2 * MiB;
constexpr size_t WS_ROPED = 3 * MiB;
constexpr size_t WS_LIST = 4 * MiB;
constexpr size_t WS_TOKSLOT = 6 * MiB;
constexpr size_t WS_TOKW = 6 * MiB + 512 * 1024;
constexpr size_t WS_H = 8 * MiB;
constexpr size_t WS_U = 40 * MiB;
constexpr size_t WS_QM = 104 * MiB;
constexpr size_t WS_KVM = 128 * MiB;
constexpr size_t WS_MIX = 160 * MiB;
constexpr size_t WS_O1 = 192 * MiB;
constexpr size_t WS_O2 = 784 * MiB;
constexpr size_t WS_Y = 208 * MiB;
constexpr size_t WS_X1 = 272 * MiB;
constexpr size_t WS_ACT = 336 * MiB;
constexpr size_t WS_YS = 432 * MiB;
constexpr size_t WS_W = 800 * MiB, W_LSTRIDE = 424 * MiB;
constexpr size_t W_IN = 0, W_UQ = 16 * MiB, W_UKV = 18 * MiB, W_O = 20 * MiB, W_R = 28 * MiB, W_GU = 32 * MiB, W_D = 292 * MiB;
constexpr size_t WS_END = WS_W + 2 * W_LSTRIDE;
static_assert(WS_ACT + (size_t)SLOT_MAX * 512 * 2 <= WS_YS && WS_YS + (size_t)SLOT_MAX * 2048 * 2 <= WS_O2 && WS_O2 + 16 * MiB <= WS_W, "ws map");
static_assert(W_GU + (size_t)NE1 * 1024 * 2048 * 2 <= W_D && W_D + (size_t)NE1 * 2048 * 512 * 2 <= W_LSTRIDE, "w map");
constexpr int CW_TMO = 0, CW_BAR = 4096, CW_CNT = 16384;
constexpr int CW_MT = 65536;

constexpr int LDS_BYTES = 147456;
constexpr int RING_BYTES = 131072;
constexpr int EXTRA_OFF = 131072;
constexpr int MISC_OFF = LDS_BYTES - 512;

#define RLX_AGENT __ATOMIC_RELAXED, __HIP_MEMORY_SCOPE_AGENT
#define LDS_WAIT() asm volatile("s_waitcnt lgkmcnt(0)" ::: "memory")
#define VM_WAIT() asm volatile("s_waitcnt vmcnt(0)" ::: "memory")

__device__ __forceinline__ unsigned cvt_pk_bf16(float lo, float hi) { unsigned r; asm volatile("v_cvt_pk_bf16_f32 %0, %1, %2" : "=v"(r) : "v"(lo), "v"(hi)); return r; }
__device__ __forceinline__ float bf2f(unsigned short b) { return __builtin_bit_cast(float, (unsigned)b << 16); }
__device__ __forceinline__ float bflo(unsigned w) { return __builtin_bit_cast(float, w << 16); }
__device__ __forceinline__ float bfhi(unsigned w) { return __builtin_bit_cast(float, w & 0xffff0000u); }
__device__ __forceinline__ float ldg_f32(const void* b, unsigned off) { return *(const float*)((const char*)b + off); }
#ifndef WT_STORES
#define WT_STORES 1
#endif
__device__ __forceinline__ void st_wt16(void* p, u32x4 v) { if (WT_STORES) asm volatile("global_store_dwordx4 %0, %1, off sc1\n\ts_nop 1" :: "v"(p), "v"(v) : "memory"); else *(u32x4*)p = v; }
__device__ __forceinline__ void st_wt8(void* p, u32x2 v) { if (WT_STORES) asm volatile("global_store_dwordx2 %0, %1, off sc1" :: "v"(p), "v"(v) : "memory"); else *(u32x2*)p = v; }
__device__ __forceinline__ void st_wt4(void* p, unsigned v) { if (WT_STORES) asm volatile("global_store_dword %0, %1, off sc1" :: "v"(p), "v"(v) : "memory"); else *(unsigned*)p = v; }
__device__ __forceinline__ void stg_f32(void* b, unsigned off, float v) { if (WT_STORES) asm volatile("global_store_dword %0, %1, %2 sc1" :: "v"(off), "v"(v), "s"(b) : "memory"); else *(float*)((char*)b + off) = v; }
__device__ __forceinline__ void stg_u16(void* b, unsigned off, unsigned short v) { if (WT_STORES) { const unsigned vv = v; asm volatile("global_store_short %0, %1, %2 sc1" :: "v"(off), "v"(vv), "s"(b) : "memory"); } else *(unsigned short*)((char*)b + off) = v; }
__device__ __forceinline__ bf16x8 ldg_b128(const void* b, unsigned off) { return *(const bf16x8*)((const char*)b + off); }
__device__ __forceinline__ int hw_wave_slot() { return (int)(__builtin_amdgcn_s_getreg((5 << 11) | 4) & 63u); }
__device__ __forceinline__ int tid_x() {
    extern __shared__ __attribute__((aligned(16))) unsigned char lds_raw_t[];
    const int w = ((volatile LAS int*)((LAS unsigned char*)lds_raw_t + MISC_OFF))[64 + hw_wave_slot()];
    int l; asm volatile("v_mbcnt_lo_u32_b32 %0, -1, 0\n\tv_mbcnt_hi_u32_b32 %0, -1, %0" : "=v"(l));
    return __builtin_amdgcn_readfirstlane(w) * 64 + l;
}
__device__ __forceinline__ int lane_id_local() { int l; asm volatile("v_mbcnt_lo_u32_b32 %0, -1, 0\n\tv_mbcnt_hi_u32_b32 %0, -1, %0" : "=v"(l)); return l; }
__device__ __forceinline__ float shfl_idx(float v, int src) { return __builtin_bit_cast(float, __builtin_amdgcn_ds_bpermute(src << 2, __builtin_bit_cast(int, v))); }
#ifndef WSUM_DPP
#define WSUM_DPP 1
#endif
__device__ __forceinline__ float wave_sum(float v) {
#if WSUM_DPP
#define WS_STEP(ctrl, rmask) v += __builtin_bit_cast(float, __builtin_amdgcn_update_dpp(0, __builtin_bit_cast(int, v), ctrl, rmask, 0xf, false))
    WS_STEP(0x111, 0xf); WS_STEP(0x112, 0xf); WS_STEP(0x114, 0xf); WS_STEP(0x118, 0xf);
    WS_STEP(0x142, 0xa); WS_STEP(0x143, 0xc);
#undef WS_STEP
    return __builtin_bit_cast(float, __builtin_amdgcn_readlane(__builtin_bit_cast(int, v), 63));
#else
    const int l = lane_id_local();
#pragma unroll
    for (int o = 1; o < 64; o <<= 1) v += shfl_idx(v, l ^ o);
    return v;
#endif
}

#define XB_TMO      128
#define XB_XCNT(j)  (256  + 64 * (j))
#define XB_XSUB(j)  (1280 + 64 * (j))
#define XB_XGEN(j)  (2304 + 64 * (j))
#define XB_TOP      3328
#define XB_TOPGEN   3392
#define XCD_BAR_WORDS 3456
#define XB_SPIN_CAP (1u << 22)

__device__ __forceinline__ unsigned xb_ld(unsigned* p)              { return __hip_atomic_load(p, __ATOMIC_RELAXED, __HIP_MEMORY_SCOPE_AGENT); }
__device__ __forceinline__ unsigned xb_add(unsigned* p, unsigned v) { return __hip_atomic_fetch_add(p, v, __ATOMIC_RELAXED, __HIP_MEMORY_SCOPE_AGENT); }
__device__ __forceinline__ unsigned xb_xcc_id() { return (unsigned)__builtin_amdgcn_s_getreg((3 << 11) | 20) & 0xFu; }
#define XB_SPIN(cond, bar) do { unsigned _sp = 0; while (cond) { __builtin_amdgcn_s_sleep(1); \
    if ((++_sp & 255u) == 0u) { if (xb_ld(&(bar)[XB_TMO])) break; if (_sp > XB_SPIN_CAP) { atomicAdd(&(bar)[XB_TMO], 1u); break; } } } } while (0)

struct XcdBarrier { unsigned* bar; unsigned x; volatile LAS unsigned* st; };

__device__ __forceinline__ XcdBarrier xcd_barrier_post(unsigned* bar, volatile LAS unsigned* st) {
    XcdBarrier b; b.bar = bar; b.x = xb_xcc_id(); b.st = st;
    if (tid_x() == 0) (void)xb_add(&bar[XB_XCNT(b.x)], 1u);
    return b;
}
__device__ __forceinline__ void xcd_barrier_complete(unsigned* bar, unsigned x, unsigned& nloc, unsigned& nx) {
    const unsigned G = gridDim.x * gridDim.y * gridDim.z;
    unsigned sum, cnt, mine, sp = 0u;
    for (;;) {
        sum = 0u; cnt = 0u; mine = 0u;
#pragma unroll
        for (unsigned j = 0; j < 16; ++j) { const unsigned c = xb_ld(&bar[XB_XCNT(j)]); sum += c; cnt += (c > 0u) ? 1u : 0u; }
        if (sum == G) break;
        __builtin_amdgcn_s_sleep(1);
        if ((++sp & 255u) == 0u) { if (xb_ld(&bar[XB_TMO])) break; if (sp > XB_SPIN_CAP) { atomicAdd(&bar[XB_TMO], 1u); break; } }
    }
    mine = xb_ld(&bar[XB_XCNT(x)]);
    nloc = mine > 0u ? mine : 1u; nx = cnt > 0u ? cnt : 1u;
}
__device__ __forceinline__ void xcd_barrier(const XcdBarrier& b) {
    asm volatile("s_waitcnt vmcnt(0)" ::: "memory");
    __syncthreads();
    if (tid_x() == 0) {
        unsigned* bar = b.bar;
        __builtin_amdgcn_s_waitcnt(0);
        unsigned nloc = b.st[0], nx = b.st[1];
        if (nloc == 0u) { xcd_barrier_complete(bar, b.x, nloc, nx); b.st[0] = nloc; b.st[1] = nx; }
        const unsigned old = xb_add(&bar[XB_XSUB(b.x)], 1u);
        const unsigned gen = old / nloc;
        if (old + 1u == (gen + 1u) * nloc) {
            __builtin_amdgcn_fence(__ATOMIC_RELEASE, "agent");
            asm volatile("s_waitcnt vmcnt(0)" ::: "memory");
            const unsigned og = xb_add(&bar[XB_TOP], 1u);
            const unsigned tg = og / nx;
            if (og + 1u == (tg + 1u) * nx) xb_add(&bar[XB_TOPGEN], 1u);
            else XB_SPIN(xb_ld(&bar[XB_TOPGEN]) == tg, bar);
            __builtin_amdgcn_fence(__ATOMIC_ACQUIRE, "agent");
            xb_add(&bar[XB_XGEN(b.x)], 1u);
            asm volatile("s_waitcnt vmcnt(0)" ::: "memory");
        } else {
            XB_SPIN(xb_ld(&bar[XB_XGEN(b.x)]) == gen, bar);
            __builtin_amdgcn_fence(__ATOMIC_ACQUIRE, "agent");
            asm volatile("s_waitcnt vmcnt(0)" ::: "memory");
        }
    }
    __syncthreads();
}

namespace pg8 {
constexpr int BM = 256, BK = 64, HALF = 128, HTB = HALF * BK * 2, STAGE_BYTES = 8 * HTB;
__host__ __device__ __forceinline__ int lds_byte(int r, int c) { const int st = (r >> 4) * 2 + (c >> 5), rr = r & 15, cc = c & 31, ob = rr * 64 + cc * 2; return st * 1024 + (ob ^ (((ob >> 9) & 1) << 5)); }
__host__ __device__ __forceinline__ void stage_rc(int b, int& R, int& C) { const int st = b / 1024, sb = b % 1024, swz = sb ^ (((sb >> 9) & 1) << 5); R = (st >> 1) * 16 + swz / 64; C = (st & 1) * 32 + (swz % 64) / 2; }
__host__ __device__ __forceinline__ int perm32(int rho) { const int n = rho >> 4, i = rho & 15; return 8 * (i >> 2) + 4 * n + (i & 3); }

typedef int v8i32 __attribute__((ext_vector_type(8)));
struct Frag2 { bf16x8 lo, hi; };
template <bool SP2, bool ALIGN_EPI, bool FP8 = false, class Epi, class Sched>
__device__ __forceinline__ void gemm_phase(LAS unsigned char* lds, const Sched& S, const Epi& E, const int K, const int s1 = 127, const int s2 = 127) {
    int tid = tid_x(); asm volatile("" : "+v"(tid));
    int s1v = s1, s2v = s2; asm volatile("" : "+v"(s1v), "+v"(s2v));
    const int wid = __builtin_amdgcn_readfirstlane(tid >> 6), lane = tid & 63, wr = wid >> 2, wc = wid & 3, fr = lane & 15, fq = lane >> 4;
    const int nt = K / BK;
    unsigned voffB[2];
#pragma unroll
    for (int i = 0; i < 2; ++i) { int R, C; stage_rc(tid * 16 + i * 8192, R, C);
        int Rb = R;
        if constexpr (Epi::PERM == 1) Rb = (R & ~31) + perm32(R & 31);
        if constexpr (Epi::PERM == 2) Rb = 64 * (R >> 5) + 16 * ((R >> 2) & 3) + 4 * ((R >> 4) & 1) + (R & 3);
        voffB[i] = (unsigned)(Rb * K + C) * 2u; }
    const size_t kstep = (size_t)(BK * 2);
    const size_t hstepB = (size_t)(Epi::PERM == 2 ? 8 : HALF) * K * 2;
    const unsigned ldsw = (unsigned)wid * 1024u;
    const int aoff = lds_byte(wr * 64 + fr, fq * 8), boff = lds_byte(wc * 32 + fr, fq * 8);
#define PG8_SA(b, h) (((b) * 2 + (h)) * HTB)
#define PG8_SB(b, h) ((4 + (b) * 2 + (h)) * HTB)
#define PG8_STAGE_B(bufoff, gbase) do { _Pragma("unroll") for (int _i = 0; _i < 2; ++_i) \
        __builtin_amdgcn_global_load_lds((const unsigned*)((const char*)(gbase) + voffB[_i]), (LAS unsigned*)(lds + (bufoff) + ldsw + _i * 8192), 16, 0, 0); } while (0)
#define PG8_STAGE_A(bufoff, kbyte, OFF, h) do { _Pragma("unroll") for (int _i = 0; _i < 2; ++_i) \
        __builtin_amdgcn_global_load_lds((const unsigned*)(Ab + (kbyte) + OFF[(h) * 2 + _i]), (LAS unsigned*)(lds + (bufoff) + ldsw + _i * 8192), 16, 0, 0); } while (0)
#define PG8_LDA(dst, b, h) do { _Pragma("unroll") for (int m = 0; m < 4; ++m) _Pragma("unroll") for (int k = 0; k < 2; ++k) dst[m][k] = *(const LAS bf16x8*)(lds + PG8_SA(b, h) + aoff + m * 2048 + k * 1024); } while (0)
#define PG8_LDB(dst, b, h) do { _Pragma("unroll") for (int n = 0; n < 2; ++n) _Pragma("unroll") for (int k = 0; k < 2; ++k) dst[n][k] = *(const LAS bf16x8*)(lds + PG8_SB(b, h) + boff + n * 2048 + k * 1024); } while (0)
#define PG8_MMA(ai, bj, At, Bt) do { __builtin_amdgcn_s_setprio(1); if constexpr (FP8) { _Pragma("unroll") for (int m = 0; m < 4; ++m) _Pragma("unroll") for (int n = 0; n < 2; ++n) \
        acc[ai][bj][m][n] = __builtin_amdgcn_mfma_scale_f32_16x16x128_f8f6f4(__builtin_bit_cast(v8i32, (Frag2){Bt[n][0], Bt[n][1]}), __builtin_bit_cast(v8i32, (Frag2){At[m][0], At[m][1]}), acc[ai][bj][m][n], 0, 0, 0, s1v, 0, s2v); } else { \
        _Pragma("unroll") for (int m = 0; m < 4; ++m) _Pragma("unroll") for (int n = 0; n < 2; ++n) _Pragma("unroll") for (int k = 0; k < 2; ++k) \
        acc[ai][bj][m][n] = __builtin_amdgcn_mfma_f32_16x16x32_bf16(Bt[n][k], At[m][k], acc[ai][bj][m][n], 0, 0, 0); } __builtin_amdgcn_s_setprio(0); } while (0)
#define PG8_WAIT_V(n) asm volatile("s_waitcnt vmcnt(" #n ")" ::: "memory")
#define PG8_WAIT_L(n) asm volatile("s_waitcnt lgkmcnt(" #n ")" ::: "memory")
#define PG8_BAR __builtin_amdgcn_s_barrier()
#define PG8_SCHED __builtin_amdgcn_sched_barrier(0)
    typename Sched::Unit cur, nxt; int ui = 0;
    if (!S.next(0, cur)) return;
    f32x4 acc[2][2][4][2];
#pragma unroll
    for (int a = 0; a < 2; ++a)
#pragma unroll
        for (int b = 0; b < 2; ++b)
#pragma unroll
            for (int m = 0; m < 4; ++m)
#pragma unroll
                for (int n = 0; n < 2; ++n) acc[a][b][m][n] = (f32x4){0.f, 0.f, 0.f, 0.f};
    bf16x8 At[4][2], B0[2][2], B1[2][2];
    unsigned ao[4], no[4];
    const char* const Ab = S.abase();
    unsigned peek = 0u;
    if constexpr (Sched::HAS_READY) S.a_ready(cur, wid, 0u);
    S.aoffs(cur, tid, ao);
    if constexpr (Sched::PREFETCH) {
#pragma unroll
        for (int j = 0; j < 4; ++j) no[j] = ao[j];
    }
    const char* cB = S.bptr(cur);
    if constexpr (SP2) {
        PG8_STAGE_B(PG8_SB(0, 0), cB); PG8_STAGE_B(PG8_SB(0, 1), cB + hstepB); PG8_STAGE_A(PG8_SA(0, 0), 0, ao, 0); PG8_STAGE_A(PG8_SA(0, 1), 0, ao, 1);
        if (wr == 1) PG8_BAR;
        PG8_WAIT_V(2); PG8_BAR;
        PG8_STAGE_B(PG8_SB(1, 0), cB + kstep); PG8_STAGE_A(PG8_SA(1, 0), kstep, ao, 0); PG8_STAGE_B(PG8_SB(1, 1), cB + hstepB + kstep);
        PG8_WAIT_V(6); PG8_BAR;
    } else {
        PG8_STAGE_B(PG8_SB(0, 0), cB); PG8_STAGE_A(PG8_SA(0, 0), 0, ao, 0); PG8_STAGE_B(PG8_SB(0, 1), cB + hstepB); PG8_STAGE_A(PG8_SA(0, 1), 0, ao, 1);
        if (wr == 1) PG8_BAR;
        PG8_WAIT_V(4); PG8_BAR;
        PG8_STAGE_B(PG8_SB(1, 0), cB + kstep); PG8_STAGE_A(PG8_SA(1, 0), kstep, ao, 0); PG8_STAGE_B(PG8_SB(1, 1), cB + hstepB + kstep);
        PG8_WAIT_V(6); PG8_BAR;
    }
    for (;;) {
        const bool has_next = S.next(ui + 1, nxt);
        if constexpr (Sched::PREFETCH) { if (has_next) S.aoffs(nxt, tid, no); }
        if constexpr (Sched::HAS_READY) { if (has_next) peek = S.a_peek(nxt); }
        const char* nB = has_next ? S.bptr(nxt) : cB;
#pragma unroll 1
        for (int t = 0; t < nt; t += 2) {
            const bool last = (t == nt - 2);
            if constexpr (Sched::HAS_READY) { if (last && has_next) S.a_ready(nxt, wid, peek); }
            const size_t ka1 = (size_t)(t + 1) * kstep;
            const size_t k2 = last ? 0 : (size_t)(t + 2) * kstep, k3 = k2 + kstep;
            const char* b2 = last ? nB : cB + (size_t)(t + 2) * kstep; const char* b3 = b2 + kstep;
            if constexpr (SP2) {
            PG8_LDB(B0, 0, 0); PG8_LDB(B1, 0, 1); PG8_SCHED; PG8_LDA(At, 0, 0); PG8_STAGE_A(PG8_SA(1, 1), ka1, ao, 1);
            if (last && has_next) {
                if constexpr (Sched::PREFETCH) {
#pragma unroll
                    for (int j = 0; j < 4; ++j) ao[j] = no[j];
                } else S.aoffs(nxt, tid, ao);
            }
            PG8_WAIT_V(8); PG8_WAIT_L(0); PG8_BAR; PG8_MMA(0, 0, At, B0); PG8_MMA(0, 1, At, B1); PG8_BAR; PG8_SCHED;
            PG8_LDA(At, 0, 1); PG8_STAGE_B(PG8_SB(0, 0), b2); PG8_STAGE_B(PG8_SB(0, 1), b2 + hstepB); PG8_STAGE_A(PG8_SA(0, 0), k2, ao, 0);
            PG8_WAIT_V(8); PG8_WAIT_L(0); PG8_BAR; PG8_MMA(1, 0, At, B0); PG8_MMA(1, 1, At, B1); PG8_BAR; PG8_SCHED;
            PG8_LDB(B0, 1, 0); PG8_LDB(B1, 1, 1); PG8_SCHED; PG8_LDA(At, 1, 0); PG8_STAGE_A(PG8_SA(0, 1), k2, ao, 1);
            PG8_WAIT_V(8); PG8_WAIT_L(0); PG8_BAR; PG8_MMA(0, 0, At, B0); PG8_MMA(0, 1, At, B1); PG8_BAR; PG8_SCHED;
            PG8_LDA(At, 1, 1); PG8_STAGE_B(PG8_SB(1, 0), b3); PG8_STAGE_B(PG8_SB(1, 1), b3 + hstepB); PG8_STAGE_A(PG8_SA(1, 0), k3, ao, 0);
            PG8_WAIT_V(8); PG8_WAIT_L(0); PG8_BAR; PG8_MMA(1, 0, At, B0); PG8_MMA(1, 1, At, B1); PG8_BAR; PG8_SCHED;
            } else {
            PG8_LDB(B0, 0, 0); PG8_SCHED; PG8_LDA(At, 0, 0); PG8_STAGE_A(PG8_SA(1, 1), ka1, ao, 1);
            if (last && has_next) {
                if constexpr (Sched::PREFETCH) {
#pragma unroll
                    for (int j = 0; j < 4; ++j) ao[j] = no[j];
                } else S.aoffs(nxt, tid, ao);
            }
            PG8_WAIT_L(8); PG8_BAR; PG8_WAIT_L(0); PG8_MMA(0, 0, At, B0); PG8_BAR; PG8_SCHED;
            PG8_LDB(B1, 0, 1); PG8_STAGE_B(PG8_SB(0, 0), b2);
            PG8_BAR; PG8_WAIT_L(0); PG8_MMA(0, 1, At, B1); PG8_BAR;
            PG8_LDA(At, 0, 1); PG8_STAGE_A(PG8_SA(0, 0), k2, ao, 0);
            PG8_BAR; PG8_WAIT_L(0); PG8_MMA(1, 0, At, B0); PG8_BAR; PG8_SCHED;
            PG8_STAGE_B(PG8_SB(0, 1), b2 + hstepB);
            PG8_WAIT_V(6); PG8_BAR; PG8_MMA(1, 1, At, B1); PG8_BAR;
            PG8_LDB(B0, 1, 0); PG8_SCHED; PG8_LDA(At, 1, 0); PG8_STAGE_A(PG8_SA(0, 1), k2, ao, 1);
            PG8_WAIT_L(8); PG8_BAR; PG8_WAIT_L(0); PG8_MMA(0, 0, At, B0); PG8_BAR; PG8_SCHED;
            PG8_LDB(B1, 1, 1); PG8_STAGE_B(PG8_SB(1, 0), b3);
            PG8_BAR; PG8_WAIT_L(0); PG8_MMA(0, 1, At, B1); PG8_BAR;
            PG8_LDA(At, 1, 1); PG8_STAGE_A(PG8_SA(1, 0), k3, ao, 0);
            PG8_BAR; PG8_WAIT_L(0); PG8_MMA(1, 0, At, B0); PG8_BAR; PG8_SCHED;
            PG8_STAGE_B(PG8_SB(1, 1), b3 + hstepB);
            PG8_WAIT_V(6); PG8_BAR; PG8_MMA(1, 1, At, B1); PG8_BAR;
                    }
        }
        if constexpr (ALIGN_EPI) { if (wr == 0) PG8_BAR; }
        E(acc, cur, wr, wc, fr, fq);
        if (!has_next) break;
#pragma unroll
        for (int a = 0; a < 2; ++a)
#pragma unroll
            for (int b = 0; b < 2; ++b)
#pragma unroll
                for (int m = 0; m < 4; ++m)
#pragma unroll
                    for (int n = 0; n < 2; ++n) acc[a][b][m][n] = (f32x4){0.f, 0.f, 0.f, 0.f};
        cur = nxt; cB = nB; ++ui;
        if constexpr (ALIGN_EPI) { if (wr == 1) PG8_BAR; }
    }
    PG8_WAIT_V(0);
    if constexpr (Epi::HAS_FINISH) E.finish(fr, fq);
    if constexpr (!ALIGN_EPI) { if (wr == 0) PG8_BAR; }
    PG8_BAR;
#undef PG8_SA
#undef PG8_SB
#undef PG8_STAGE_A
#undef PG8_STAGE_B
#undef PG8_LDA
#undef PG8_LDB
#undef PG8_MMA
#undef PG8_WAIT_V
#undef PG8_WAIT_L
#undef PG8_BAR
#undef PG8_SCHED
}

struct DUnit { int pm, pn, orow0, ocol0; };
struct DenseSched {
    const char* A; unsigned ldaB; const char* Bt; int K; int nM, nN, nwg, G, c;
    typedef DUnit Unit;
    __device__ __forceinline__ void init(const void* A_, int lda_elems, const void* Bt_, int M, int N, int K_, int G_, int c_) {
        A = (const char*)A_; ldaB = (unsigned)lda_elems * 2u; Bt = (const char*)Bt_; K = K_; nM = M / 256; nN = N / 256; nwg = nM * nN; G = G_; c = c_; }
    __device__ __forceinline__ bool next(int i, Unit& u) const {
        const int L = i * G + c; if (L >= nwg) return false;
        int wgid = L; { const int q = nwg / 8, r = nwg % 8, xcd = wgid % 8, off = wgid / 8; wgid = (xcd < r ? xcd * (q + 1) : r * (q + 1) + (xcd - r) * q) + off; }
        const int nig = 8 * nN, gid = wgid / nig, fm = gid * 8, gsz = (nM - fm) < 8 ? (nM - fm) : 8;
        u.pm = fm + ((wgid % nig) % gsz); u.pn = (wgid % nig) / gsz; u.orow0 = u.pm * 256; u.ocol0 = u.pn * 256; return true;
    }
    __device__ __forceinline__ const char* abase() const { return A; }
    static constexpr bool PREFETCH = false, HAS_READY = false;
    __device__ __forceinline__ void aoffs(const Unit& u, int tid, unsigned (&o)[4]) const {
#pragma unroll
        for (int i = 0; i < 2; ++i) { int R, C; stage_rc(tid * 16 + i * 8192, R, C);
#pragma unroll
            for (int h = 0; h < 2; ++h) o[h * 2 + i] = (unsigned)(u.pm * 256 + h * 128 + R) * ldaB + (unsigned)(C * 2); }
    }
    __device__ __forceinline__ const char* bptr(const Unit& u) const { return Bt + (size_t)u.pn * 256 * K * 2; }
};

struct MUnit { int e, mt, pn, orow0, ocol0; };
struct MoeGUSched {
    const char* Hb; const char* W; const int* list; const LAS int* pref; const LAS int* cnt; int total, G, c;
    unsigned rowB;
    typedef MUnit Unit;
    __device__ __forceinline__ bool next(int i, Unit& u) const {
        const int L = i * G + c; if (L >= total) return false;
        const int mtg = L >> 2; u.pn = L & 3;
        int e = pref[400 + mtg];
        e = __builtin_amdgcn_readfirstlane(e);
        u.e = e; u.mt = mtg - pref[e]; u.orow0 = mtg * 256; u.ocol0 = u.pn * 128; return true;
    }
    __device__ __forceinline__ const char* abase() const { return Hb; }
    static constexpr bool PREFETCH = true, HAS_READY = false;
    __device__ __forceinline__ void aoffs(const Unit& u, int tid, unsigned (&o)[4]) const {
        const int n = cnt[u.e];
#pragma unroll
        for (int i = 0; i < 2; ++i) { int R, C; stage_rc(tid * 16 + i * 8192, R, C);
#pragma unroll
            for (int h = 0; h < 2; ++h) { const int pos = u.mt * 256 + h * 128 + R;
                int tok = pos; if (u.e < 64) tok = (pos < n) ? list[u.e * 8192 + pos] : 0;
                o[h * 2 + i] = (unsigned)tok * rowB + (unsigned)(C * 2); } }
    }
    __device__ __forceinline__ const char* bptr(const Unit& u) const { return W + ((size_t)u.e * 1024 + (size_t)u.pn * 256) * rowB; }
};
struct MoeDownSched {
    const char* Act; const char* W; const LAS int* pref; int total, G, c;
    int n6, lead;
    unsigned* ready;
    unsigned* tmo;
    unsigned rowB;
    typedef MUnit Unit;
    __device__ __forceinline__ unsigned a_peek(const Unit& u) const { return __hip_atomic_load(ready + 64 * (u.orow0 >> 8), __ATOMIC_RELAXED, __HIP_MEMORY_SCOPE_AGENT); }
    __device__ __forceinline__ void a_ready(const Unit& u, int wid, unsigned peeked) const {
        if (wid == 0) {
            unsigned* w = ready + 64 * (u.orow0 >> 8); unsigned sp = 0;
            if ((unsigned)__builtin_amdgcn_readfirstlane(peeked) < 32u)
            while ((unsigned)__builtin_amdgcn_readfirstlane(__hip_atomic_load(w, __ATOMIC_RELAXED, __HIP_MEMORY_SCOPE_AGENT)) < 32u) {
                __builtin_amdgcn_s_sleep(2);
                if ((++sp & 255u) == 0u) { if (__hip_atomic_load(tmo, __ATOMIC_RELAXED, __HIP_MEMORY_SCOPE_AGENT) != 0u) break;
                    if (sp > (1u << 22)) { __hip_atomic_store(tmo, 1u, __ATOMIC_RELAXED, __HIP_MEMORY_SCOPE_AGENT); break; } }
            }
            __builtin_amdgcn_fence(__ATOMIC_ACQUIRE, "agent");
            asm volatile("s_waitcnt vmcnt(0)" ::: "memory");
        }
        __builtin_amdgcn_s_barrier();
    }
    __device__ __forceinline__ bool next(int i, Unit& u) const {
        int L;
        if (lead) L = (i < DOWN_LEAD) ? i * (G - n6) + c : DOWN_LEAD * (G - n6) + (i - DOWN_LEAD) * G + c;
        else L = DOWN_LEAD * (G - n6) + i * G + c;
        if (L >= total) return false;
        const int mtg = L >> 3; u.pn = L & 7;
        int e = pref[400 + mtg];
        e = __builtin_amdgcn_readfirstlane(e);
        u.e = e; u.mt = mtg - pref[e]; u.orow0 = mtg * 256; u.ocol0 = u.pn * 256; return true;
    }
    __device__ __forceinline__ const char* abase() const { return Act; }
    static constexpr bool PREFETCH = false, HAS_READY = true;
    __device__ __forceinline__ void aoffs(const Unit& u, int tid, unsigned (&o)[4]) const {
#pragma unroll
        for (int i = 0; i < 2; ++i) { int R, C; stage_rc(tid * 16 + i * 8192, R, C);
#pragma unroll
            for (int h = 0; h < 2; ++h) o[h * 2 + i] = (unsigned)(u.orow0 + h * 128 + R) * rowB + (unsigned)(C * 2); }
    }
    __device__ __forceinline__ const char* bptr(const Unit& u) const { return W + ((size_t)u.e * 2048 + (size_t)u.pn * 256) * rowB; }
};

template <bool NT = false> struct EpiBf16T {
    static constexpr int PERM = 1; static constexpr bool HAS_FINISH = false;
    bf16* O; int ldc;
    template <class U> __device__ __forceinline__ void operator()(const f32x4 (&acc)[2][2][4][2], const U& u, int wr, int wc, int fr, int fq) const {
        const int row0 = u.orow0 + wr * 64 + fr, col0 = u.ocol0 + wc * 32 + 8 * fq;
#pragma unroll
        for (int ai = 0; ai < 2; ++ai)
#pragma unroll
            for (int m = 0; m < 4; ++m) { bf16* rowp = O + (size_t)(row0 + ai * HALF + m * 16) * ldc + col0;
#pragma unroll
                for (int bj = 0; bj < 2; ++bj) { const f32x4 v0 = acc[ai][bj][m][0], v1 = acc[ai][bj][m][1];
                    u32x4 w; w.x = cvt_pk_bf16(v0[0], v0[1]); w.y = cvt_pk_bf16(v0[2], v0[3]); w.z = cvt_pk_bf16(v1[0], v1[1]); w.w = cvt_pk_bf16(v1[2], v1[3]);
                    if constexpr (NT) __builtin_nontemporal_store(w, (u32x4*)(rowp + bj * HALF)); else st_wt16(rowp + bj * HALF, w); } }
    }
};
typedef EpiBf16T<false> EpiBf16;
struct EpiFp8 {
    static constexpr int PERM = 2; static constexpr bool HAS_FINISH = false;
    unsigned char* O; int ldc; float scale;
    template <class U> __device__ __forceinline__ void operator()(const f32x4 (&acc)[2][2][4][2], const U& u, int wr, int wc, int fr, int fq) const {
        const int row0 = u.orow0 + wr * 64 + fr, col0 = u.ocol0 + wc * 64 + 16 * fq;
#pragma unroll
        for (int ai = 0; ai < 2; ++ai)
#pragma unroll
            for (int m = 0; m < 4; ++m) { u32x4 w;
#pragma unroll
                for (int bj = 0; bj < 2; ++bj) { const f32x4 v0 = acc[ai][bj][m][0] * scale, v1 = acc[ai][bj][m][1] * scale;
                    int a = __builtin_amdgcn_cvt_pk_fp8_f32(clamp8(v0[0]), clamp8(v0[1]), 0, false); a = __builtin_amdgcn_cvt_pk_fp8_f32(clamp8(v0[2]), clamp8(v0[3]), a, true);
                    int b = __builtin_amdgcn_cvt_pk_fp8_f32(clamp8(v1[0]), clamp8(v1[1]), 0, false); b = __builtin_amdgcn_cvt_pk_fp8_f32(clamp8(v1[2]), clamp8(v1[3]), b, true);
                    if (bj == 0) { w.x = (unsigned)a; w.y = (unsigned)b; } else { w.z = (unsigned)a; w.w = (unsigned)b; } }
                st_wt16(O + (size_t)(row0 + ai * HALF + m * 16) * ldc + col0, w); }
    }
};
__device__ __forceinline__ float silu_mul(float g, float u) { return g * u * __builtin_amdgcn_rcpf(1.f + __builtin_amdgcn_exp2f(-1.4426950408889634f * g)); }
template <bool F8> struct EpiGateUpT {
    static constexpr int PERM = 1;
    bf16* O; unsigned* ready; mutable int pend = -1;
    static constexpr bool HAS_FINISH = true;
    __device__ __forceinline__ void finish(int fr, int fq) const {
        if (pend >= 0 && fr == 0 && fq == 0) __hip_atomic_fetch_add(ready + 64 * pend, 1u, __ATOMIC_RELAXED, __HIP_MEMORY_SCOPE_AGENT);
        pend = -1; }
    template <class U> __device__ __forceinline__ void operator()(const f32x4 (&acc)[2][2][4][2], const U& u, int wr, int wc, int fr, int fq) const {
        if (pend >= 0 && fr == 0 && fq == 0) __hip_atomic_fetch_add(ready + 64 * pend, 1u, __ATOMIC_RELAXED, __HIP_MEMORY_SCOPE_AGENT);
        pend = u.orow0 >> 8;
        const int row0 = u.orow0 + wr * 64 + fr, col0 = u.ocol0 + wc * 32 + 8 * fq;
        const __amdgpu_buffer_rsrc_t rs = __builtin_amdgcn_make_buffer_rsrc(O, 0, (unsigned)((size_t)SLOT_MAX * FFE * 2), 0x00020000);
#pragma unroll
        for (int ai = 0; ai < 2; ++ai)
#pragma unroll
            for (int m = 0; m < 4; ++m) { const unsigned eo = (unsigned)((row0 + ai * HALF + m * 16) * FFE + col0);
                const f32x4 g0 = acc[ai][0][m][0], g1 = acc[ai][0][m][1], u0 = acc[ai][1][m][0], u1 = acc[ai][1][m][1];
                if constexpr (F8) {
                    int a = __builtin_amdgcn_cvt_pk_fp8_f32(clamp8(silu_mul(g0[0], u0[0]) * ACT8_SCALE), clamp8(silu_mul(g0[1], u0[1]) * ACT8_SCALE), 0, false);
                    a = __builtin_amdgcn_cvt_pk_fp8_f32(clamp8(silu_mul(g0[2], u0[2]) * ACT8_SCALE), clamp8(silu_mul(g0[3], u0[3]) * ACT8_SCALE), a, true);
                    int b = __builtin_amdgcn_cvt_pk_fp8_f32(clamp8(silu_mul(g1[0], u1[0]) * ACT8_SCALE), clamp8(silu_mul(g1[1], u1[1]) * ACT8_SCALE), 0, false);
                    b = __builtin_amdgcn_cvt_pk_fp8_f32(clamp8(silu_mul(g1[2], u1[2]) * ACT8_SCALE), clamp8(silu_mul(g1[3], u1[3]) * ACT8_SCALE), b, true);
                    __builtin_amdgcn_raw_buffer_store_b64((u32x2){(unsigned)a, (unsigned)b}, rs, eo, 0, 16);
                } else {
                u32x4 w; w.x = cvt_pk_bf16(silu_mul(g0[0], u0[0]), silu_mul(g0[1], u0[1])); w.y = cvt_pk_bf16(silu_mul(g0[2], u0[2]), silu_mul(g0[3], u0[3]));
                w.z = cvt_pk_bf16(silu_mul(g1[0], u1[0]), silu_mul(g1[1], u1[1])); w.w = cvt_pk_bf16(silu_mul(g1[2], u1[2]), silu_mul(g1[3], u1[3]));
                __builtin_amdgcn_raw_buffer_store_b128(w, rs, eo * 2u, 0, 16); } }
    }
};
typedef EpiGateUpT<false> EpiGateUp;
struct EpiResid {
    static constexpr int PERM = 0; static constexpr bool HAS_FINISH = false;
    const float* X; const float* gate  ; float* Y;
    template <class U> __device__ __forceinline__ void operator()(const f32x4 (&acc)[2][2][4][2], const U& u, int wr, int wc, int fr, int fq) const {
        const int row0 = u.orow0 + wr * 64 + fr, col0 = u.ocol0 + wc * 32 + 4 * fq; const int b = u.orow0 >> 12;
        f32x4 gv[2][2];
#pragma unroll
        for (int bj = 0; bj < 2; ++bj)
#pragma unroll
            for (int n = 0; n < 2; ++n) gv[bj][n] = *(const f32x4*)(gate + (size_t)b * ADA_W + col0 + bj * HALF + 16 * n) + 1.0f;
#pragma unroll
        for (int ai = 0; ai < 2; ++ai)
#pragma unroll
            for (int m = 0; m < 4; ++m) { const size_t ro = (size_t)(row0 + ai * HALF + m * 16) * DM + col0;
#pragma unroll
                for (int bj = 0; bj < 2; ++bj)
#pragma unroll
                    for (int n = 0; n < 2; ++n) { const f32x4 xv = *(const f32x4*)(X + ro + bj * HALF + 16 * n);
                        st_wt16(Y + ro + bj * HALF + 16 * n, __builtin_bit_cast(u32x4, xv * DN_ALPHA + gv[bj][n] * acc[ai][bj][m][n])); } }
    }
};
}

namespace att {
constexpr int NW = 8;
enum { MODE_MLA = 0, MODE_NA = 1, MODE_DIFF = 2 };
constexpr float LOG2E = 1.4426950408889634f;
constexpr float THR = 8.f;
constexpr int SHM_V = 16384, SHM_K = 24576;
constexpr int LDS_VBUF = 0, LDS_KBUF = 3 * SHM_V, LDS_WS = LDS_KBUF + 3 * SHM_K, LDS_RPB = LDS_WS + NW * 64 * 4, LDS_END = LDS_RPB + 2048;
static_assert(LDS_END <= MISC_OFF, "attention LDS");
#define KSWZ128(row, colB) ((row) * 256 + ((colB) ^ (((row) & 15) << 4)))
#define KSWZ64(row, colB)  ((row) * 128 + ((colB) ^ ((((row) >> 1) & 7) << 4)))
#define SBAR() __builtin_amdgcn_sched_barrier(0)
__device__ __forceinline__ int crow(int r, int hi) { return (r & 3) + 8 * (r >> 2) + 4 * hi; }

struct AttnP {
    const bf16* U; const bf16* QM; const bf16* KVM; bf16* MIX; float* O1; float* O2;
    const f32x2* ropeM; const float* rpb  ;
};

template <int MODE> struct Cfg;
template <> struct Cfg<MODE_MLA>  { static constexpr float SCALE = 0.07216878364870322f; static constexpr int NQ = 12; };
template <> struct Cfg<MODE_NA>   { static constexpr float SCALE = 0.08838834764831845f; static constexpr int NQ = 8; };
template <> struct Cfg<MODE_DIFF> { static constexpr float SCALE = 0.125f;               static constexpr int NQ = 4; };

template <int MODE>
__device__ __forceinline__ void partialSM(f32x16& p0, f32x16& p1, float& m_reg, float& mn, float& alpha) {
    constexpr float SCALE = Cfg<MODE>::SCALE, C = SCALE * LOG2E;
    float pmax = p0[0];
#pragma unroll
    for (int r = 1; r < 16; ++r) pmax = fmaxf(pmax, p0[r]);
#pragma unroll
    for (int r = 0; r < 16; ++r) pmax = fmaxf(pmax, p1[r]);
    { auto rr = __builtin_amdgcn_permlane32_swap(__float_as_uint(pmax), __float_as_uint(pmax), false, false);
      pmax = fmaxf(__uint_as_float(rr[0]), __uint_as_float(rr[1])); }
    if (__builtin_expect(__all(pmax - m_reg <= THR / SCALE), 1)) { mn = m_reg; alpha = 1.f; }
    else { mn = fmaxf(m_reg, pmax); alpha = __builtin_amdgcn_exp2f((m_reg - mn) * C); m_reg = mn; }
    const float mnC = -mn * C;
#pragma unroll
    for (int r = 0; r < 16; ++r) p0[r] = fmaf(p0[r], C, mnC);
#pragma unroll
    for (int r = 0; r < 16; ++r) p1[r] = fmaf(p1[r], C, mnC);
#pragma unroll
    for (int r = 0; r < 16; ++r) p0[r] = __builtin_amdgcn_exp2f(p0[r]);
}
__device__ __forceinline__ void finishSM(f32x16& p0, f32x16& p1, float alpha, float& l_reg, bf16x8& pa0, bf16x8& pa1, bf16x8& pa2, bf16x8& pa3) {
#pragma unroll
    for (int r = 0; r < 16; ++r) p1[r] = __builtin_amdgcn_exp2f(p1[r]);
    float ps = 0;
#pragma unroll
    for (int r = 0; r < 16; ++r) ps += p0[r];
#pragma unroll
    for (int r = 0; r < 16; ++r) ps += p1[r];
    { auto rr = __builtin_amdgcn_permlane32_swap(__float_as_uint(ps), __float_as_uint(ps), false, false);
      ps = __uint_as_float(rr[0]) + __uint_as_float(rr[1]); }
    l_reg = l_reg * alpha + ps;
#define PK4(P, BASE, OUT) do { unsigned a0 = cvt_pk_bf16(P[BASE + 0], P[BASE + 1]), a1 = cvt_pk_bf16(P[BASE + 2], P[BASE + 3]);   \
    unsigned b0 = cvt_pk_bf16(P[BASE + 4], P[BASE + 5]), b1 = cvt_pk_bf16(P[BASE + 6], P[BASE + 7]);                              \
    auto r0 = __builtin_amdgcn_permlane32_swap(a0, b0, false, false); auto r1 = __builtin_amdgcn_permlane32_swap(a1, b1, false, false); \
    u32x4 w = {r0[0], r1[0], r0[1], r1[1]}; OUT = __builtin_bit_cast(bf16x8, w); } while (0)
    PK4(p0, 0, pa0); PK4(p0, 8, pa1); PK4(p1, 0, pa2); PK4(p1, 8, pa3);
#undef PK4
}
#ifndef QK_PD
#define QK_PD 3
#endif
#ifndef ATT2
#define ATT2 4
#endif
#ifndef ATT_GLDS
#define ATT_GLDS 1
#endif
template <int MODE, int D0>
__device__ __forceinline__ void kfrag(const LAS char* Kb, int r32, int hi, bf16x8& b0, bf16x8& b1) {
    if constexpr (MODE == MODE_DIFF) { constexpr int cbase = D0 * 32; const int cb = cbase + hi * 16;
        b0 = *(const LAS bf16x8*)(Kb + KSWZ64(r32, cb)); b1 = *(const LAS bf16x8*)(Kb + KSWZ64(32 + r32, cb)); }
    else if constexpr (D0 < 8) { const int cb = D0 * 32 + hi * 16;
        b0 = *(const LAS bf16x8*)(Kb + KSWZ128(r32, cb)); b1 = *(const LAS bf16x8*)(Kb + KSWZ128(32 + r32, cb)); }
    else { const int cb = (D0 - 8) * 32 + hi * 16; const LAS char* Kr = Kb + 16384;
        b0 = *(const LAS bf16x8*)(Kr + KSWZ64(r32, cb)); b1 = *(const LAS bf16x8*)(Kr + KSWZ64(32 + r32, cb)); }
}
template <int MODE, int D0, int NS>
__device__ __forceinline__ void qk_step(f32x16& p0, f32x16& p1, const LAS char* Kb, const bf16x8* qr, int r32, int hi, bf16x8 (&f0)[NS], bf16x8 (&f1)[NS]) {
    if constexpr (D0 < NS) {
        if constexpr (D0 + QK_PD < NS) kfrag<MODE, D0 + QK_PD>(Kb, r32, hi, f0[D0 + QK_PD], f1[D0 + QK_PD]);
        p0 = __builtin_amdgcn_mfma_f32_32x32x16_bf16(f0[D0], qr[D0], p0, 0, 0, 0);
        p1 = __builtin_amdgcn_mfma_f32_32x32x16_bf16(f1[D0], qr[D0], p1, 0, 0, 0);
        SBAR();
        qk_step<MODE, D0 + 1, NS>(p0, p1, Kb, qr, r32, hi, f0, f1);
    }
}
template <int MODE>
__device__ __forceinline__ void qkt(f32x16& p0, f32x16& p1, const LAS char* Kb, const bf16x8* qr, int r32, int hi) {
    constexpr int NS = Cfg<MODE>::NQ;
    p0 = f32x16{}; p1 = f32x16{};
    bf16x8 f0[NS], f1[NS];
    kfrag<MODE, 0>(Kb, r32, hi, f0[0], f1[0]);
    if constexpr (QK_PD > 1 && NS > 1) kfrag<MODE, 1>(Kb, r32, hi, f0[1], f1[1]);
    if constexpr (QK_PD > 2 && NS > 2) kfrag<MODE, 2>(Kb, r32, hi, f0[2], f1[2]);
    if constexpr (QK_PD > 3 && NS > 3) kfrag<MODE, 3>(Kb, r32, hi, f0[3], f1[3]);
    SBAR();
    qk_step<MODE, 0, NS>(p0, p1, Kb, qr, r32, hi, f0, f1);
}
__device__ __forceinline__ int v_st(int k, int c) { const int kk = (k & ~0xC) | ((k & 4) << 1) | ((k & 8) >> 1); return ((kk >> 3) * 4 + (c >> 5)) * 512 + ((kk & 7) * 32 + (c & 31)) * 2; }
__device__ __forceinline__ int v_rd_base(int lane) { return ((lane & 3) << 3) | (((lane >> 2) & 3) << 6) | (((lane >> 4) & 1) << 5) | (((lane >> 5) & 1) << 8); }
constexpr int v_rd_off(int d0, int ks, int half) { return d0 * 512 + ks * 4096 + half * 2048; }
template <int OFF> __device__ __forceinline__ s16x4 tr_read(int vb) {
    s16x4 r; asm volatile("ds_read_b64_tr_b16 %0, %1 offset:%2" : "=&v"(r) : "v"(vb), "i"(OFF) : "memory"); return r;
}
template <int D0> __device__ __forceinline__ void pv_one(f32x16& od, int vb, bf16x8 pa0, bf16x8 pa1, bf16x8 pa2, bf16x8 pa3) {
    const s16x4 l0 = tr_read<v_rd_off(D0, 0, 0)>(vb), h0 = tr_read<v_rd_off(D0, 0, 1)>(vb), l1 = tr_read<v_rd_off(D0, 1, 0)>(vb), h1 = tr_read<v_rd_off(D0, 1, 1)>(vb);
    const s16x4 l2 = tr_read<v_rd_off(D0, 2, 0)>(vb), h2 = tr_read<v_rd_off(D0, 2, 1)>(vb), l3 = tr_read<v_rd_off(D0, 3, 0)>(vb), h3 = tr_read<v_rd_off(D0, 3, 1)>(vb);
    asm volatile("s_waitcnt lgkmcnt(0)" ::: "memory"); SBAR();
#define PK(L, H) (bf16x8){L[0], L[1], L[2], L[3], H[0], H[1], H[2], H[3]}
    od = __builtin_amdgcn_mfma_f32_32x32x16_bf16(pa0, PK(l0, h0), od, 0, 0, 0);
    od = __builtin_amdgcn_mfma_f32_32x32x16_bf16(pa1, PK(l1, h1), od, 0, 0, 0);
    od = __builtin_amdgcn_mfma_f32_32x32x16_bf16(pa2, PK(l2, h2), od, 0, 0, 0);
    od = __builtin_amdgcn_mfma_f32_32x32x16_bf16(pa3, PK(l3, h3), od, 0, 0, 0);
#undef PK
}
__device__ __forceinline__ void pv_d0(f32x16* o, int vb, bf16x8 pa0, bf16x8 pa1, bf16x8 pa2, bf16x8 pa3) {
    pv_one<0>(o[0], vb, pa0, pa1, pa2, pa3); pv_one<1>(o[1], vb, pa0, pa1, pa2, pa3); pv_one<2>(o[2], vb, pa0, pa1, pa2, pa3); pv_one<3>(o[3], vb, pa0, pa1, pa2, pa3);
}
__device__ __forceinline__ void na_bias_mask(f32x16& p0, f32x16& p1, const LAS float* rpbL, int kr, int rq, int qc, int hi) {
    constexpr float INVS = 11.313708498984761f;
    const int r0 = min(max(rq - 4, 0), 56);
    const bool tv = (kr >= r0) && (kr < r0 + 8);
    const int dr = min(max(kr - rq + 7, 0), 14);
    const int c0 = min(max(qc - 8, 0), 48);
    const LAS float* row = rpbL + dr * 31;
    const float NINF = -__builtin_huge_valf();
#pragma unroll
    for (int r = 0; r < 16; ++r) { const int kc = crow(r, hi);
        const bool ok = tv && kc >= c0 && kc < c0 + 16; const int ix = min(max(kc - qc + 15, 0), 30); const float bv = row[ix]; p0[r] = ok ? fmaf(bv, INVS, p0[r]) : NINF; }
    SBAR();
#pragma unroll
    for (int r = 0; r < 16; ++r) { const int kc2 = crow(r, hi) + 32;
        const bool ok = tv && kc2 >= c0 && kc2 < c0 + 16; const int ix = min(max(kc2 - qc + 15, 0), 30); const float bv = row[ix]; p1[r] = ok ? fmaf(bv, INVS, p1[r]) : NINF; }
}

template <int MODE, int PASS = 0>
__device__ __forceinline__ void attn_unit(const AttnP& P, const int uid, LAS char* lds) {
    constexpr int NQ = Cfg<MODE>::NQ;
    constexpr int NH = (MODE == MODE_MLA) ? 8 : 4;
    int tid = tid_x(); asm volatile("" : "+v"(tid));
    const int wid = tid >> 6, lane = tid & 63, r32 = lane & 31, hi = lane >> 5;
    const int qb = uid & 15, h = (uid >> 4) % NH, b = (uid >> 4) / NH;
    const int tok0 = b * SEQ;
    const int qrow = tok0 + qb * 256 + wid * 32 + r32;
    LAS char* V_lds = lds + LDS_VBUF; LAS char* K_lds = lds + LDS_KBUF;
    LAS float* ws = (LAS float*)(lds + LDS_WS) + wid * 64; LAS float* li_l = ws; LAS float* al_l = ws + 32;
    LAS float* rpbL = (LAS float*)(lds + LDS_RPB);
    const int sr = tid >> 4, sc = (tid & 15) * 8, vst0 = v_st(sr, sc), vst1 = v_st(32 + sr, sc);
    const int sr64 = tid >> 3, sc64 = (tid & 7) * 8;
    const int vb0 = (int)(unsigned)(uintptr_t)V_lds + v_rd_base(lane);
    int NT = 64, kbase = tok0;
    int rq = 0, qc = 0, kr_lo = 0;
    if constexpr (MODE == MODE_NA) { const int rq0 = qb * 4; kr_lo = min(min(max(rq0 - 4, 0), 56), 52); NT = 12; kbase = tok0 + kr_lo * 64; rq = rq0 + (wid >> 1); qc = (wid & 1) * 32 + r32;
        for (int i = tid; i < 15 * 31; i += 512) rpbL[i] = P.rpb[h * 465 + i];
        __syncthreads(); }
    const bf16* Kg; const bf16* Vg; const bf16* Kg2 = nullptr; int ldk, ldv;
    if constexpr (MODE == MODE_MLA) { Kg = P.KVM + h * 256; Vg = P.KVM + h * 256 + 128; Kg2 = P.U + U_KR; ldk = KVW; ldv = KVW; }
    else if constexpr (MODE == MODE_NA) { Kg = P.U + U_NA + 512 + h * 128; Vg = P.U + U_NA + 1024 + h * 128; ldk = UW; ldv = UW; }
    else { Kg = P.U + U_DF + 512 + h * 128; Vg = P.U + U_DF + 1024 + h * 128; ldk = UW; ldv = UW; }

    constexpr int pass = PASS;
    constexpr bool HALF_OFFSET = false;
    {
        float m_reg = -1e30f, l_reg = 0; f32x16 o[4] = {}; bf16x8 qr[NQ];
        if constexpr (MODE == MODE_MLA) {
            const bf16* Qw = P.QM + (size_t)qrow * QMW + h * 192 + hi * 8;
#pragma unroll
            for (int d0 = 0; d0 < 12; ++d0) qr[d0] = *(const bf16x8*)(Qw + d0 * 16);
            const f32x2* rt = P.ropeM + (size_t)(qrow & (SEQ - 1)) * 32;
#pragma unroll
            for (int g = 0; g < 2; ++g) {
                bf16x8 x1 = qr[8 + g], x2 = qr[10 + g];
#pragma unroll
                for (int e = 0; e < 8; ++e) { const f32x2 cs = rt[g * 16 + hi * 8 + e];
                    const float a = bf2f((unsigned short)x1[e]), c = bf2f((unsigned short)x2[e]);
                    const float ra = a * cs.x - c * cs.y, rc = c * cs.x + a * cs.y;
                    x1[e] = (short)(cvt_pk_bf16(ra, 0.f) & 0xffffu); x2[e] = (short)(cvt_pk_bf16(rc, 0.f) & 0xffffu); }
                qr[8 + g] = x1; qr[10 + g] = x2;
            }
        } else if constexpr (MODE == MODE_NA) {
            const bf16* Qw = P.U + (size_t)qrow * UW + U_NA + h * 128 + hi * 8;
#pragma unroll
            for (int d0 = 0; d0 < 8; ++d0) qr[d0] = *(const bf16x8*)(Qw + d0 * 16);
        } else {
            const bf16* Qw = P.U + (size_t)qrow * UW + U_DF + h * 128 + pass * 64 + hi * 8;
#pragma unroll
            for (int d0 = 0; d0 < 4; ++d0) qr[d0] = *(const bf16x8*)(Qw + d0 * 16);
        }
        const bf16* Kp = (MODE == MODE_DIFF) ? Kg + pass * 64 : Kg;
        bf16x8 s_v0, s_v1, s_k0, s_k1, s_k2;
        const unsigned voffA = (unsigned)(sr * ldv + sc) * 2u, voffB = (unsigned)((32 + sr) * ldv + sc) * 2u;
        const unsigned koffA = (unsigned)(sr * ldk + sc) * 2u, koffB = (unsigned)((32 + sr) * ldk + sc) * 2u;
        const unsigned koff64 = (unsigned)(sr64 * ldk + sc64) * 2u, k2off = (unsigned)(sr64 * UW + sc64) * 2u;
#define SLOAD(t) do { const size_t kt = (size_t)(kbase + (t) * 64); const bf16* Vt = Vg + kt * ldv; const bf16* Kt = Kp + kt * ldk; \
        s_v0 = ldg_b128(Vt, voffA); s_v1 = ldg_b128(Vt, voffB); \
        if constexpr (MODE == MODE_DIFF) { s_k0 = ldg_b128(Kt, koff64); } \
        else { s_k0 = ldg_b128(Kt, koffA); s_k1 = ldg_b128(Kt, koffB); \
               if constexpr (MODE == MODE_MLA) s_k2 = ldg_b128(Kg2 + kt * UW, k2off); } } while (0)
#define SWRITE(bf) do { LAS char* Vb_ = V_lds + (bf) * SHM_V; LAS char* Kb_ = K_lds + (bf) * SHM_K; \
        *(LAS bf16x8*)(Vb_ + vst0) = s_v0; *(LAS bf16x8*)(Vb_ + vst1) = s_v1; \
        if constexpr (MODE == MODE_DIFF) { *(LAS bf16x8*)(Kb_ + KSWZ64(sr64, sc64 * 2)) = s_k0; } \
        else { *(LAS bf16x8*)(Kb_ + KSWZ128(sr, sc * 2)) = s_k0; *(LAS bf16x8*)(Kb_ + KSWZ128(32 + sr, sc * 2)) = s_k1; \
               if constexpr (MODE == MODE_MLA) *(LAS bf16x8*)(Kb_ + 16384 + KSWZ64(sr64, sc64 * 2)) = s_k2; } } while (0)
#define RESC(a) do { if (__any((a) < 1.f)) { if (hi == 0) al_l[r32] = (a); asm volatile("s_waitcnt lgkmcnt(0)" ::: "memory"); \
        _Pragma("unroll") for (int d = 0; d < 4; ++d) _Pragma("unroll") for (int r = 0; r < 16; ++r) o[d][r] *= al_l[crow(r, hi)]; } } while (0)
#define NAMASK(pa_, pb_, t) do { if constexpr (MODE == MODE_NA) na_bias_mask(pa_, pb_, rpbL, kr_lo + (t), rq, qc, hi); } while (0)
        f32x16 p0, p1; float mn, al; bf16x8 pa0, pa1, pa2, pa3;
        if constexpr (HALF_OFFSET) {
        SLOAD(0); VM_WAIT(); SWRITE(0); SLOAD(1); __syncthreads();
        const int grp = __builtin_amdgcn_readfirstlane(wid) >> 2;
#pragma unroll 1
        for (int sl = 0; sl < 2 * NT + 1; ++sl) {
            if (sl & 1) { const int t = sl >> 1; if (t + 1 < NT) { VM_WAIT(); SWRITE((t + 1) & 1); } if (t + 2 < NT) SLOAD(t + 2); }
            SBAR();
            const int rel = sl - grp, tt = rel >> 1;
            if (rel >= 0 && tt < NT) {
                bool act = true;
                if constexpr (MODE == MODE_NA) { const int kr = kr_lo + tt, r0w = min(max(rq - 4, 0), 56); act = (kr >= r0w) && (kr < r0w + 8); }
                if (act) {
                    if ((rel & 1) == 0) { qkt<MODE>(p0, p1, K_lds + (tt & 1) * SHM_K, qr, r32, hi); NAMASK(p0, p1, tt); }
                    else { partialSM<MODE>(p0, p1, m_reg, mn, al);
                        RESC(al);
                        finishSM(p0, p1, al, l_reg, pa0, pa1, pa2, pa3); SBAR();
                        pv_d0(o, vb0 + (tt & 1) * SHM_V, pa0, pa1, pa2, pa3); }
                }
            }
            __syncthreads();
        }
        } else if constexpr (ATT_GLDS && ((ATT2 >> MODE) & 1) && MODE != MODE_NA) {
        unsigned gsv[2], gsk[2], gsk2 = 0u;
#pragma unroll
        for (int i = 0; i < 2; ++i) { const int a = (i * 512 + tid) * 16;
            { const int sub = a >> 9, within = a & 511; const int kk = (sub >> 2) * 8 + (within >> 6); const int k = (kk & ~0xC) | ((kk & 4) << 1) | ((kk & 8) >> 1);
              const int c = (sub & 3) * 32 + ((within & 63) >> 1); gsv[i] = (unsigned)(k * ldv + c) * 2u; }
            if constexpr (MODE == MODE_DIFF) { if (i == 0) { const int row = a >> 7, ch = ((a >> 4) & 7) ^ ((row >> 1) & 7); gsk[0] = (unsigned)(row * ldk + ch * 8) * 2u; } gsk[1] = 0u; }
            else { const int row = a >> 8, ch = ((a >> 4) & 15) ^ (row & 15); gsk[i] = (unsigned)(row * ldk + ch * 8) * 2u; } }
        if constexpr (MODE == MODE_MLA) { const int a = tid * 16, row = a >> 7, ch = ((a >> 4) & 7) ^ ((row >> 1) & 7); gsk2 = (unsigned)(row * UW + ch * 8) * 2u; }
        const unsigned ldsw = (unsigned)__builtin_amdgcn_readfirstlane(wid) * 1024u;
#define GLDS3(t) do { const int bf_ = (t) % 3; const size_t kt = (size_t)(kbase + (t) * 64); const char* Vt = (const char*)(Vg + kt * ldv); const char* Kt = (const char*)(Kp + kt * ldk); \
        LAS char* Vb_ = V_lds + bf_ * SHM_V + ldsw; LAS char* Kb_ = K_lds + bf_ * SHM_K + ldsw; \
        __builtin_amdgcn_global_load_lds((const unsigned*)(Vt + gsv[0]), (LAS unsigned*)(Vb_), 16, 0, 0); __builtin_amdgcn_global_load_lds((const unsigned*)(Vt + gsv[1]), (LAS unsigned*)(Vb_ + 8192), 16, 0, 0); \
        __builtin_amdgcn_global_load_lds((const unsigned*)(Kt + gsk[0]), (LAS unsigned*)(Kb_), 16, 0, 0); \
        if constexpr (MODE != MODE_DIFF) __builtin_amdgcn_global_load_lds((const unsigned*)(Kt + gsk[1]), (LAS unsigned*)(Kb_ + 8192), 16, 0, 0); \
        if constexpr (MODE == MODE_MLA) __builtin_amdgcn_global_load_lds((const unsigned*)((const char*)(Kg2 + kt * UW) + gsk2), (LAS unsigned*)(Kb_ + 16384), 16, 0, 0); } while (0)
#define KB3(t) (K_lds + ((t) % 3) * SHM_K)
#define VB3(t) (vb0 + ((t) % 3) * SHM_V)
        f32x16 pB0, pB1; float mnB, alB;
        GLDS3(0); GLDS3(1); VM_WAIT(); __syncthreads();
        qkt<MODE>(p0, p1, KB3(0), qr, r32, hi); partialSM<MODE>(p0, p1, m_reg, mn, al);
#pragma unroll 1
        for (int j = 1; j + 1 < NT; j += 2) {
            GLDS3(j + 1);
            SBAR(); qkt<MODE>(pB0, pB1, KB3(j), qr, r32, hi);
            finishSM(p0, p1, al, l_reg, pa0, pa1, pa2, pa3); SBAR();
            pv_d0(o, VB3(j - 1), pa0, pa1, pa2, pa3); partialSM<MODE>(pB0, pB1, m_reg, mnB, alB);
            RESC(alB); VM_WAIT(); __syncthreads();
            if (j + 2 < NT) GLDS3(j + 2);
            SBAR(); qkt<MODE>(p0, p1, KB3(j + 1), qr, r32, hi);
            finishSM(pB0, pB1, alB, l_reg, pa0, pa1, pa2, pa3); SBAR();
            pv_d0(o, VB3(j), pa0, pa1, pa2, pa3); partialSM<MODE>(p0, p1, m_reg, mn, al);
            RESC(al); VM_WAIT(); __syncthreads();
        }
        SBAR(); qkt<MODE>(pB0, pB1, KB3(NT - 1), qr, r32, hi);
        finishSM(p0, p1, al, l_reg, pa0, pa1, pa2, pa3); SBAR();
        pv_d0(o, VB3(NT - 2), pa0, pa1, pa2, pa3); partialSM<MODE>(pB0, pB1, m_reg, mnB, alB);
        RESC(alB);
        finishSM(pB0, pB1, alB, l_reg, pa0, pa1, pa2, pa3); SBAR();
        pv_d0(o, VB3(NT - 1), pa0, pa1, pa2, pa3);
        __syncthreads();
#undef GLDS3
#undef KB3
#undef VB3
        } else if constexpr (ATT_GLDS) {
        unsigned gsv[2], gsk[2], gsk2 = 0u;
#pragma unroll
        for (int i = 0; i < 2; ++i) { const int a = (i * 512 + tid) * 16;
            { const int sub = a >> 9, within = a & 511; const int kk = (sub >> 2) * 8 + (within >> 6); const int k = (kk & ~0xC) | ((kk & 4) << 1) | ((kk & 8) >> 1);
              const int c = (sub & 3) * 32 + ((within & 63) >> 1); gsv[i] = (unsigned)(k * ldv + c) * 2u; }
            if constexpr (MODE == MODE_DIFF) { if (i == 0) { const int row = a >> 7, ch = ((a >> 4) & 7) ^ ((row >> 1) & 7); gsk[0] = (unsigned)(row * ldk + ch * 8) * 2u; } gsk[1] = 0u; }
            else { const int row = a >> 8, ch = ((a >> 4) & 15) ^ (row & 15); gsk[i] = (unsigned)(row * ldk + ch * 8) * 2u; } }
        if constexpr (MODE == MODE_MLA) { const int a = tid * 16, row = a >> 7, ch = ((a >> 4) & 7) ^ ((row >> 1) & 7); gsk2 = (unsigned)(row * UW + ch * 8) * 2u; }
        const unsigned ldsw = (unsigned)__builtin_amdgcn_readfirstlane(wid) * 1024u;
#define GLDS(t, bf) do { const size_t kt = (size_t)(kbase + (t) * 64); const char* Vt = (const char*)(Vg + kt * ldv); const char* Kt = (const char*)(Kp + kt * ldk); \
        LAS char* Vb_ = V_lds + (bf) * SHM_V + ldsw; LAS char* Kb_ = K_lds + (bf) * SHM_K + ldsw; \
        __builtin_amdgcn_global_load_lds((const unsigned*)(Vt + gsv[0]), (LAS unsigned*)(Vb_), 16, 0, 0); __builtin_amdgcn_global_load_lds((const unsigned*)(Vt + gsv[1]), (LAS unsigned*)(Vb_ + 8192), 16, 0, 0); \
        __builtin_amdgcn_global_load_lds((const unsigned*)(Kt + gsk[0]), (LAS unsigned*)(Kb_), 16, 0, 0); \
        if constexpr (MODE != MODE_DIFF) __builtin_amdgcn_global_load_lds((const unsigned*)(Kt + gsk[1]), (LAS unsigned*)(Kb_ + 8192), 16, 0, 0); \
        if constexpr (MODE == MODE_MLA) __builtin_amdgcn_global_load_lds((const unsigned*)((const char*)(Kg2 + kt * UW) + gsk2), (LAS unsigned*)(Kb_ + 16384), 16, 0, 0); } while (0)
        GLDS(0, 0); VM_WAIT(); __syncthreads();
#pragma unroll 1
        for (int t = 0; t < NT; ++t) {
            const int bf = t & 1;
            if (t + 1 < NT) GLDS(t + 1, bf ^ 1);
            SBAR();
            bool act = true;
            if constexpr (MODE == MODE_NA) { const int kr = kr_lo + t, r0w = min(max(rq - 4, 0), 56); act = (kr >= r0w) && (kr < r0w + 8); }
            if (act) {
            qkt<MODE>(p0, p1, K_lds + bf * SHM_K, qr, r32, hi); NAMASK(p0, p1, t);
            partialSM<MODE>(p0, p1, m_reg, mn, al);
            RESC(al);
            finishSM(p0, p1, al, l_reg, pa0, pa1, pa2, pa3); SBAR();
            pv_d0(o, vb0 + bf * SHM_V, pa0, pa1, pa2, pa3);
            }
            VM_WAIT();
            __syncthreads();
        }
#undef GLDS
        } else {
        SLOAD(0); VM_WAIT(); SWRITE(0); SLOAD(1); __syncthreads();
#pragma unroll 1
        for (int t = 0; t < NT; ++t) {
            const int bf = t & 1;
            if (t + 1 < NT) { VM_WAIT(); SWRITE(bf ^ 1); }
            SBAR();
            bool act = true;
            if constexpr (MODE == MODE_NA) { const int kr = kr_lo + t, r0w = min(max(rq - 4, 0), 56); act = (kr >= r0w) && (kr < r0w + 8); }
            if (act) {
            qkt<MODE>(p0, p1, K_lds + bf * SHM_K, qr, r32, hi); NAMASK(p0, p1, t);
            partialSM<MODE>(p0, p1, m_reg, mn, al);
            RESC(al);
            finishSM(p0, p1, al, l_reg, pa0, pa1, pa2, pa3); SBAR();
            }
            if (t + 2 < NT) SLOAD(t + 2);
            SBAR();
            if (act) pv_d0(o, vb0 + bf * SHM_V, pa0, pa1, pa2, pa3);
            __syncthreads();
        }
        }
        int r32e = r32, hie = hi; asm volatile("" : "+v"(r32e), "+v"(hie));
        if (hi == 0) li_l[r32] = l_reg; asm volatile("s_waitcnt lgkmcnt(0)" ::: "memory");
#pragma unroll
        for (int r = 0; r < 16; ++r) { const float rl = __builtin_amdgcn_rcpf(li_l[crow(r, hie)]);
#pragma unroll
            for (int d0 = 0; d0 < 4; ++d0) o[d0][r] *= rl; }
        const int orow0 = tok0 + qb * 256 + __builtin_amdgcn_readfirstlane(wid) * 32;
        if constexpr (MODE == MODE_DIFF) {
            float* O1b = (pass == 0 ? P.O1 : P.O2) + (size_t)orow0 * 512 + h * 128;
            const unsigned o1off = (unsigned)(hie * 4 * 512 + r32e) * 4u;
#pragma unroll
            for (int r = 0; r < 16; ++r)
#pragma unroll
                for (int d0 = 0; d0 < 4; ++d0) stg_f32(O1b + crow(r, 0) * 512, o1off + (unsigned)(d0 * 128), o[d0][r]);
        } else {
            bf16* Mb = P.MIX + (size_t)orow0 * DM + ((MODE == MODE_MLA) ? h * 128 : 1024 + h * 128);
            const unsigned moff = (unsigned)(hie * 4 * DM + r32e) * 2u;
#pragma unroll
            for (int r = 0; r < 16; ++r)
#pragma unroll
                for (int d0 = 0; d0 < 4; ++d0) stg_u16(Mb + crow(r, 0) * DM, moff + (unsigned)(d0 * 64), (unsigned short)(cvt_pk_bf16(o[d0][r], 0.f) & 0xffffu));
        }
        __syncthreads();
#undef SLOAD
#undef SWRITE
#undef RESC
#undef NAMASK
    }
}
}

struct Args {
    const float* in[28]; float* out; unsigned char* ws; int ph_lo, ph_hi;
};
typedef const __attribute__((address_space(4))) unsigned char* kaptr;
struct KA {
    kaptr p;
    __device__ __forceinline__ const float* in(int i) const { return *(const float* const __attribute__((address_space(4)))*)(p + 8 * i); }
    __device__ __forceinline__ float* out() const { return *(float* const __attribute__((address_space(4)))*)(p + 224); }
    __device__ __forceinline__ unsigned char* ws() const { return *(unsigned char* const __attribute__((address_space(4)))*)(p + 232); }
    __device__ __forceinline__ int ph_lo() const { return *(const __attribute__((address_space(4))) int*)(p + 240); }
    __device__ __forceinline__ int ph_hi() const { return *(const __attribute__((address_space(4))) int*)(p + 244); }
};
__device__ __forceinline__ KA fresh_ka() { kaptr p = (kaptr)__builtin_amdgcn_kernarg_segment_ptr(); asm volatile("" : "+s"(p)); return KA{p}; }
static_assert(sizeof(Args) == 248, "Args layout");
struct Frame {
    LAS unsigned char* lds; volatile LAS unsigned* MISC; unsigned* ctl;
    int tid, lane, wave, G, gw, NGW;
};
constexpr int NPHASE = 2 + 8 * NLAYER;
#ifndef GEMM_SP2
#define GEMM_SP2 true
#endif
#ifndef CONV_QUOTA
#define CONV_QUOTA 7
#endif

struct CvtDesc { const float* src; unsigned char* dst; int N, dKB, f8; };
__device__ __forceinline__ void cvt_load(const CvtDesc& d, float (&t)[64], int lane) {
    const float* p = d.src + (size_t)(lane >> 4) * d.N + 4 * (lane & 15);
#pragma unroll
    for (int i = 0; i < 16; ++i) { const f32x4 v = __builtin_nontemporal_load((const f32x4*)(p + (size_t)(4 * i) * d.N));
        t[4 * i] = v.x; t[4 * i + 1] = v.y; t[4 * i + 2] = v.z; t[4 * i + 3] = v.w; }
}
__device__ __forceinline__ void cvt_finish(const CvtDesc& d, const float (&t)[64], LAS float* scr, int lane) {
    LAS float* sw = scr + (lane >> 4) * 65 + 4 * (lane & 15);
#pragma unroll
    for (int i = 0; i < 16; ++i) { sw[(4 * i) * 65] = t[4 * i]; sw[(4 * i) * 65 + 1] = t[4 * i + 1]; sw[(4 * i) * 65 + 2] = t[4 * i + 2]; sw[(4 * i) * 65 + 3] = t[4 * i + 3]; }
    LDS_WAIT();
    const int c = lane & 7;
    if (d.f8) {
#pragma unroll
        for (int j = 0; j < 8; ++j) { const int n = (lane >> 3) + 8 * j; const LAS float* s = scr + (8 * c) * 65 + n;
            int a = __builtin_amdgcn_cvt_pk_fp8_f32(clamp8(s[0 * 65] * W8_SCALE), clamp8(s[1 * 65] * W8_SCALE), 0, false); a = __builtin_amdgcn_cvt_pk_fp8_f32(clamp8(s[2 * 65] * W8_SCALE), clamp8(s[3 * 65] * W8_SCALE), a, true);
            int b = __builtin_amdgcn_cvt_pk_fp8_f32(clamp8(s[4 * 65] * W8_SCALE), clamp8(s[5 * 65] * W8_SCALE), 0, false); b = __builtin_amdgcn_cvt_pk_fp8_f32(clamp8(s[6 * 65] * W8_SCALE), clamp8(s[7 * 65] * W8_SCALE), b, true);
            __builtin_nontemporal_store((u32x2){(unsigned)a, (unsigned)b}, (u32x2*)(d.dst + (size_t)n * d.dKB + 8 * c)); }
    } else {
#pragma unroll
        for (int j = 0; j < 8; ++j) { const int n = (lane >> 3) + 8 * j; const LAS float* s = scr + (8 * c) * 65 + n;
            u32x4 o; o.x = cvt_pk_bf16(s[0 * 65], s[1 * 65]); o.y = cvt_pk_bf16(s[2 * 65], s[3 * 65]); o.z = cvt_pk_bf16(s[4 * 65], s[5 * 65]); o.w = cvt_pk_bf16(s[6 * 65], s[7 * 65]);
            __builtin_nontemporal_store(o, (u32x4*)(d.dst + (size_t)n * d.dKB + 16 * c)); }
    }
    LDS_WAIT();
}
__device__ __forceinline__ void cvt_item(const float* W, int N, int k0, int n0, bf16* WT, size_t dst_row0, int dK, LAS float* scr, int lane) {
    CvtDesc d; d.src = W + (size_t)k0 * N + n0; d.dst = (unsigned char*)(WT + dst_row0 * dK + k0); d.N = N; d.dKB = dK * 2; d.f8 = 0;
    float t[64]; cvt_load(d, t, lane); cvt_finish(d, t, scr, lane);
}

__device__ __forceinline__ void sincos_rev(double t, float& c, float& s) {
    const int q = (int)(t * 4.0 + 0.5);
    const double r = (t - 0.25 * q) * 6.283185307179586476925;
    const double r2 = r * r;
    const double sn = r * (1.0 + r2 * (-1.0 / 6 + r2 * (1.0 / 120 + r2 * (-1.0 / 5040 + r2 * (1.0 / 362880 + r2 * (-1.0 / 39916800 + r2 * (1.0 / 6227020800.0)))))));
    const double cs = 1.0 + r2 * (-0.5 + r2 * (1.0 / 24 + r2 * (-1.0 / 720 + r2 * (1.0 / 40320 + r2 * (-1.0 / 3628800 + r2 * (1.0 / 479001600.0 + r2 * (-1.0 / 87178291200.0)))))));
    double co, si;
    switch (q & 3) { case 0: co = cs; si = sn; break; case 1: co = -sn; si = cs; break; case 2: co = -cs; si = -sn; break; default: co = sn; si = -cs; break; }
    c = (float)co; s = (float)si;
}

__device__ __forceinline__ void row_stats(const f32x4 (&v)[8], float& mean, float& rstd) {
    float s = 0.f;
#pragma unroll
    for (int j = 0; j < 8; ++j) s += (v[j].x + v[j].y) + (v[j].z + v[j].w);
    mean = wave_sum(s) * (1.f / DM);
    float s2 = 0.f;
#pragma unroll
    for (int j = 0; j < 8; ++j) { const f32x4 d = v[j] - mean; s2 += (d.x * d.x + d.y * d.y) + (d.z * d.z + d.w * d.w); }
    rstd = rsqrtf(wave_sum(s2) * (1.f / DM) + LN_EPS);
}

constexpr int CW_Q = 32768;
constexpr int Q_IG = NE1 * 256, Q_PER_L = 3 * Q_IG, Q_TOTAL = NLAYER * Q_PER_L;
__device__ __forceinline__ CvtDesc conv_expert_desc(const KA& a, unsigned char* ws, int q) {
    const int l = q / Q_PER_L; int r = q - l * Q_PER_L;
    unsigned char* wl = ws + WS_W + (size_t)l * W_LSTRIDE;
    CvtDesc d; d.f8 = (MOE_FP8_LAST && (MOE_FP8_GU_ALL || l == NLAYER - 1)) ? 1 : 0;
    if (MOE_FP8_LAST && MOE_FP8_DOWN_ALL && r >= 2 * Q_IG) d.f8 = 1;
    const int eb = d.f8 ? 1 : 2;
    if (r < 2 * Q_IG) { const int up = r >= Q_IG; if (up) r -= Q_IG; const int e = r >> 8, rr = r & 255, kb = rr >> 3, nb = rr & 7, n0 = nb * 64;
        const float* src = e < 64 ? a.in(up ? 21 : 20) + ((size_t)l * 64 + e) * DM * FFE : a.in(up ? 24 : 23) + (size_t)l * DM * FFE;
        d.src = src + (size_t)(kb * 64) * FFE + n0; d.N = FFE; d.dKB = DM * eb;
        d.dst = wl + W_GU + ((size_t)e * 1024 * DM + (size_t)((n0 >> 7) * 256 + up * 128 + (n0 & 127)) * DM + kb * 64) * eb;
    } else { r -= 2 * Q_IG; const int e = r >> 8, rr = r & 255, kb = rr >> 5, nb = rr & 31;
        const float* src = e < 64 ? a.in(22) + ((size_t)l * 64 + e) * FFE * DM : a.in(25) + (size_t)l * FFE * DM;
        d.src = src + (size_t)(kb * 64) * DM + nb * 64; d.N = DM; d.dKB = FFE * eb;
        d.dst = wl + W_D + ((size_t)e * DM * FFE + (size_t)(nb * 64) * FFE + kb * 64) * eb; }
    return d;
}
__device__ __forceinline__ void conv_expert_item(const KA& a, unsigned char* ws, int q, LAS float* scr, int lane) {
    const CvtDesc d = conv_expert_desc(a, ws, q); float t[64]; cvt_load(d, t, lane); cvt_finish(d, t, scr, lane);
}
__device__ __forceinline__ void conv_drain(const KA& a, unsigned char* ws, LAS unsigned char* lds, int target, int max_claims = 0x7fffffff) {
    volatile LAS unsigned* st = (volatile LAS unsigned*)(lds + MISC_OFF) + 8;
    unsigned* qw = (unsigned*)(ws + WS_CTL) + CW_Q;
    int tl = tid_x(); asm volatile("" : "+v"(tl));
    const int wave = __builtin_amdgcn_readfirstlane(tl >> 6), lane = tl & 63;
    LAS float* scr = (LAS float*)(lds + wave * 16640);
    __syncthreads();
    unsigned ahead = 0xFFFFFFFFu;
    if (tl == 0 && max_claims > 0) { if (xb_ld(qw) < (unsigned)target) ahead = xb_add(qw, 32u); }
    for (int nc = 0; nc < max_claims; ++nc) {
        if (tl == 0) { st[6] = ahead; if (ahead < (unsigned)target && nc + 1 < max_claims) ahead = (ahead + 32u < (unsigned)target) ? xb_add(qw, 32u) : 0xFFFFFFFFu; }
        __syncthreads();
        const unsigned base = st[6];
        if (base < (unsigned)Q_TOTAL) {
            const int q0 = (int)base + wave; const bool v0 = q0 < Q_TOTAL, v1 = q0 + 8 < Q_TOTAL, v2 = q0 + 16 < Q_TOTAL, v3 = q0 + 24 < Q_TOTAL;
            float ta[64], tb[64]; CvtDesc da, db;
            if (v0) { da = conv_expert_desc(a, ws, q0); cvt_load(da, ta, lane); }
            if (v1) { db = conv_expert_desc(a, ws, q0 + 8); cvt_load(db, tb, lane); }
            if (v0) cvt_finish(da, ta, scr, lane);
            if (v2) { da = conv_expert_desc(a, ws, q0 + 16); cvt_load(da, ta, lane); }
            if (v1) cvt_finish(db, tb, scr, lane);
            if (v3) { db = conv_expert_desc(a, ws, q0 + 24); cvt_load(db, tb, lane); }
            if (v2) cvt_finish(da, ta, scr, lane);
            if (v3) cvt_finish(db, tb, scr, lane);
        }
        if (base >= (unsigned)target) break;
        __syncthreads();
    }
    __syncthreads();
}
__device__ __forceinline__ void xcd_barrier_work(const XcdBarrier& b, const KA& a, unsigned char* ws, LAS unsigned char* lds) {
    asm volatile("s_waitcnt vmcnt(0)" ::: "memory");
    __syncthreads();
    volatile LAS unsigned* st = b.st;
    unsigned* bar = b.bar; asm volatile("" : "+s"(bar));
    unsigned* qw = (unsigned*)(ws + WS_CTL) + CW_Q;
    if (tid_x() == 0) {
        __builtin_amdgcn_s_waitcnt(0);
        unsigned nloc = st[0], nx = st[1];
        if (nloc == 0u) { xcd_barrier_complete(bar, b.x, nloc, nx); st[0] = nloc; st[1] = nx; }
        const unsigned old = xb_add(&bar[XB_XSUB(b.x)], 1u);
        const unsigned gen = old / nloc;
        if (old + 1u == (gen + 1u) * nloc) {
            __builtin_amdgcn_fence(__ATOMIC_RELEASE, "agent");
            asm volatile("s_waitcnt vmcnt(0)" ::: "memory");
            const unsigned og = xb_add(&bar[XB_TOP], 1u);
            const unsigned tg = og / nx;
            if (og + 1u == (tg + 1u) * nx) xb_add(&bar[XB_TOPGEN], 1u);
            else XB_SPIN(xb_ld(&bar[XB_TOPGEN]) == tg, bar);
            __builtin_amdgcn_fence(__ATOMIC_ACQUIRE, "agent");
            xb_add(&bar[XB_XGEN(b.x)], 1u);
            asm volatile("s_waitcnt vmcnt(0)" ::: "memory");
            st[4] = 1u;
        } else { st[4] = 0u; st[5] = gen; }
    }
    __syncthreads();
    int tl = tid_x(); asm volatile("" : "+v"(tl));
    const int wave = __builtin_amdgcn_readfirstlane(tl >> 6), lane = tl & 63;
    LAS float* scr = (LAS float*)(lds + wave * 16640);
    unsigned spins = 0;
    while (st[4] == 0u) {
        if (tl == 0) {
            if (xb_ld(&bar[XB_XGEN(b.x)]) != st[5] || xb_ld(&bar[XB_TMO]) != 0u) {
                __builtin_amdgcn_fence(__ATOMIC_ACQUIRE, "agent");
                asm volatile("s_waitcnt vmcnt(0)" ::: "memory");
                st[4] = 1u;
            } else {
                if (++spins > XB_SPIN_CAP) atomicAdd(&bar[XB_TMO], 1u);
                unsigned base = 0xFFFFFFFFu;
                if (st[7] == 0u) { base = xb_add(qw, 8u); if (base >= (unsigned)Q_TOTAL) st[7] = 1u; }
                st[6] = base;
            }
        }
        __syncthreads();
        if (st[4] != 0u) break;
        const unsigned base = st[6];
        if (base < (unsigned)Q_TOTAL) { if (base + wave < (unsigned)Q_TOTAL) conv_expert_item(a, ws, (int)base + wave, scr, lane); }
        else __builtin_amdgcn_s_sleep(4);
        __syncthreads();
    }
    __syncthreads();
}

__device__ __forceinline__ void p0_prologue(Frame& F, const KA& a) {
    unsigned char* ws = a.ws();
    {
        LAS float* sc = (LAS float*)F.lds; LAS float* red = (LAS float*)(F.lds + 16384);
        const float* cin = a.in(1);
        for (int idx = F.tid; idx < 2 * DM; idx += 512) { const float cv = cin[idx]; sc[idx] = cv * __builtin_amdgcn_rcpf(1.f + __builtin_amdgcn_exp2f(-1.4426950408889634f * cv)); }
        __syncthreads();
        for (int task = blockIdx.x; task < 256; task += F.G) {
            const int l = task >> 7, c0 = (task & 127) * 96;
            const float* Wp = a.in(2) + (size_t)l * DM * ADA_W + c0 + F.lane;
            const bool two = F.lane < 32;
            float a00 = 0.f, a01 = 0.f, a10 = 0.f, a11 = 0.f;
            const int kb = F.wave * 256;
#pragma unroll 1
            for (int k0 = 0; k0 < 256; k0 += 32) {
                float w0[32], w1[32];
#pragma unroll
                for (int k = 0; k < 32; ++k) { w0[k] = __builtin_nontemporal_load(Wp + (size_t)(kb + k0 + k) * ADA_W); w1[k] = two ? __builtin_nontemporal_load(Wp + (size_t)(kb + k0 + k) * ADA_W + 64) : 0.f; }
#pragma unroll
                for (int k = 0; k < 32; ++k) { const float s0 = sc[kb + k0 + k], s1 = sc[DM + kb + k0 + k];
                    a00 = fmaf(s0, w0[k], a00); a01 = fmaf(s0, w1[k], a01); a10 = fmaf(s1, w0[k], a10); a11 = fmaf(s1, w1[k], a11); }
            }
            red[(F.wave * 2 + 0) * 96 + F.lane] = a00; red[(F.wave * 2 + 1) * 96 + F.lane] = a10;
            if (two) { red[(F.wave * 2 + 0) * 96 + 64 + F.lane] = a01; red[(F.wave * 2 + 1) * 96 + 64 + F.lane] = a11; }
            __syncthreads();
            if (F.tid < 192) { const int b = F.tid / 96, j = F.tid % 96; float s = 0.f;
#pragma unroll
                for (int w = 0; w < 8; ++w) s += red[(w * 2 + b) * 96 + j];
                ((float*)(ws + WS_ADA))[(size_t)(l * 2 + b) * ADA_W + c0 + j] = s + a.in(3)[(size_t)l * ADA_W + c0 + j]; }
            __syncthreads();
        }
    }
    {
        f32x2* rm = (f32x2*)(ws + WS_ROPEM); f32x2* rd = (f32x2*)(ws + WS_ROPED);
        for (int idx = blockIdx.x * 512 + F.tid; idx < SEQ * 40; idx += F.G * 512) {
            const int pos = idx / 40, j = idx % 40;
            const int jj = j < 32 ? j : j - 32; const double base = j < 32 ? 0.66360123769608848 : 0.19392274474868576;
            double inv = 1.0; for (int q = 0; q < jj; ++q) inv *= base;
            double t = (double)pos * inv * 0.15915494309189533577; t -= floor(t);
            float c, s; sincos_rev(t, c, s);
            if (j < 32) rm[pos * 32 + j] = (f32x2){c, s}; else rd[pos * 8 + jj] = (f32x2){c, s};
        }
    }
    {
        LAS float* scr = (LAS float*)(F.lds + F.wave * 16640);
        constexpr int I_IN = 32 * 61, I_UQ = 8 * 24, I_UKV = 4 * 32, I_O = 32 * 32, I_R = 32;
        constexpr int PER_L = I_IN + I_UQ + I_UKV + I_O + I_R;
        for (int it = F.gw; it < NLAYER * PER_L; it += F.NGW) {
            const int l = it / PER_L; int r = it - l * PER_L;
            unsigned char* wl = ws + WS_W + (size_t)l * W_LSTRIDE;
            if (r < I_IN) { const int kb = r / 61, nb = r % 61, n0 = nb * 64; const int d0 = n0 < 832 ? n0 : n0 + 192;
                cvt_item(a.in(4) + (size_t)l * DM * 3904, 3904, kb * 64, n0, (bf16*)(wl + W_IN), d0, DM, scr, F.lane); continue; } r -= I_IN;
            if (r < I_UQ) { const int kb = r / 24, nb = r % 24;
                cvt_item(a.in(6) + (size_t)l * 512 * 1536, 1536, kb * 64, nb * 64, (bf16*)(wl + W_UQ), nb * 64, 512, scr, F.lane); continue; } r -= I_UQ;
            if (r < I_UKV) { const int kb = r / 32, nb = r % 32;
                cvt_item(a.in(8) + (size_t)l * 256 * 2048, 2048, kb * 64, nb * 64, (bf16*)(wl + W_UKV), nb * 64, 256, scr, F.lane); continue; } r -= I_UKV;
            if (r < I_O) { const int kb = r / 32, nb = r % 32;
                cvt_item(a.in(15) + (size_t)l * DM * DM, DM, kb * 64, nb * 64, (bf16*)(wl + W_O), nb * 64, DM, scr, F.lane); continue; } r -= I_O;
            cvt_item(a.in(18) + (size_t)l * DM * 64, 64, r * 64, 0, (bf16*)(wl + W_R), 0, DM, scr, F.lane);
        }
        for (int l = 0; l < NLAYER; ++l) { u32x4* z = (u32x4*)(ws + WS_W + (size_t)l * W_LSTRIDE + W_IN + (size_t)832 * DM * 2);
            for (int i = blockIdx.x * 512 + F.tid; i < 192 * DM * 2 / 16; i += F.G * 512) z[i] = (u32x4){0u, 0u, 0u, 0u}; }
    }
}

__device__ __forceinline__ void ln_mod_row(const float* xrow, const float* sh, const float* sc, bf16* hrow, int lane) {
    f32x4 v[8];
#pragma unroll
    for (int j = 0; j < 8; ++j) v[j] = *(const f32x4*)(xrow + 4 * lane + 256 * j);
    float mean, rstd; row_stats(v, mean, rstd);
#pragma unroll
    for (int j = 0; j < 8; ++j) { const f32x4 s1 = *(const f32x4*)(sc + 4 * lane + 256 * j) + 1.0f, s0 = *(const f32x4*)(sh + 4 * lane + 256 * j);
        const f32x4 y = (v[j] - mean) * rstd * s1 + s0;
        u32x2 w; w.x = cvt_pk_bf16(y.x, y.y); w.y = cvt_pk_bf16(y.z, y.w); st_wt8(hrow + 4 * lane + 256 * j, w); }
}

__device__ __forceinline__ void post_u_row(bf16* urow, int pos, const float* gq, const float* gkv, const f32x2* ropeM, const f32x2* ropeD, int lane) {
    u32x4 wq = *(u32x4*)(urow + U_CQ + 8 * lane);
    u32x2 wk = *(u32x2*)(urow + U_CKV + 4 * lane);
    const int lr = lane & 31;
    const unsigned short kra = *(const unsigned short*)(urow + U_KR + lr), krc = *(const unsigned short*)(urow + U_KR + 32 + lr);
    const f32x2 csk = ropeM[(size_t)pos * 32 + lr];
    unsigned short da[2], dc[2]; f32x2 csd[2];
#pragma unroll
    for (int t = 0; t < 2; ++t) { const int pi = lane + 64 * t, blk = pi >> 3, j = pi & 7; const bf16* p = urow + U_DF + blk * 64 + j;
        da[t] = *(const unsigned short*)(p); dc[t] = *(const unsigned short*)(p + 8); csd[t] = ropeD[(size_t)pos * 8 + j]; }
    const f32x4 g0 = *(const f32x4*)(gq + 8 * lane), g1 = *(const f32x4*)(gq + 8 * lane + 4), gk = *(const f32x4*)(gkv + 4 * lane);
    asm volatile("" ::: "memory");
    {
        float x[8] = {bflo(wq.x), bfhi(wq.x), bflo(wq.y), bfhi(wq.y), bflo(wq.z), bfhi(wq.z), bflo(wq.w), bfhi(wq.w)};
        float ss = 0.f;
#pragma unroll
        for (int i = 0; i < 8; ++i) ss += x[i] * x[i];
        const float rs = rsqrtf(wave_sum(ss) * (1.f / 512.f) + RMS_EPS);
        wq.x = cvt_pk_bf16(x[0] * rs * g0.x, x[1] * rs * g0.y); wq.y = cvt_pk_bf16(x[2] * rs * g0.z, x[3] * rs * g0.w);
        wq.z = cvt_pk_bf16(x[4] * rs * g1.x, x[5] * rs * g1.y); wq.w = cvt_pk_bf16(x[6] * rs * g1.z, x[7] * rs * g1.w);
    }
    {
        float x[4] = {bflo(wk.x), bfhi(wk.x), bflo(wk.y), bfhi(wk.y)};
        const float ss = x[0] * x[0] + x[1] * x[1] + x[2] * x[2] + x[3] * x[3];
        const float rs = rsqrtf(wave_sum(ss) * (1.f / 256.f) + RMS_EPS);
        wk.x = cvt_pk_bf16(x[0] * rs * gk.x, x[1] * rs * gk.y); wk.y = cvt_pk_bf16(x[2] * rs * gk.z, x[3] * rs * gk.w);
    }
    *(u32x4*)(urow + U_CQ + 8 * lane) = wq;
    *(u32x2*)(urow + U_CKV + 4 * lane) = wk;
    if (lane < 32) {
        const float a = bf2f(kra), c = bf2f(krc);
        urow[U_KR + lane] = (bf16)(cvt_pk_bf16(a * csk.x - c * csk.y, 0.f) & 0xffffu);
        urow[U_KR + 32 + lane] = (bf16)(cvt_pk_bf16(c * csk.x + a * csk.y, 0.f) & 0xffffu);
    }
#pragma unroll
    for (int t = 0; t < 2; ++t) {
        const int pi = lane + 64 * t, blk = pi >> 3, j = pi & 7;
        bf16* p = urow + U_DF + blk * 64 + j;
        const float a = bf2f(da[t]), c = bf2f(dc[t]);
        p[0] = (bf16)(cvt_pk_bf16(a * csd[t].x - c * csd[t].y, 0.f) & 0xffffu);
        p[8] = (bf16)(cvt_pk_bf16(c * csd[t].x + a * csd[t].y, 0.f) & 0xffffu);
    }
}

__device__ __forceinline__ void diff_combine_row(const float* o1, const float* o2, bf16* mrow, float lam, const float* subln, float omli, int lane) {
    const f32x2 g = *(const f32x2*)(subln + 2 * lane);
    f32x2 av[4], cv[4];
#pragma unroll
    for (int h = 0; h < 4; ++h) { av[h] = __builtin_nontemporal_load((const f32x2*)(o1 + h * 128 + 2 * lane)); cv[h] = __builtin_nontemporal_load((const f32x2*)(o2 + h * 128 + 2 * lane)); }
    asm volatile("" ::: "memory");
#pragma unroll
    for (int h = 0; h < 4; ++h) {
        const f32x2 a = av[h], c = cv[h];
        const f32x2 d = a - c * lam;
        const float rs = rsqrtf(wave_sum(d.x * d.x + d.y * d.y) * (1.f / 128.f) + RMS_EPS);
        *(unsigned*)(mrow + 1536 + h * 128 + 2 * lane) = cvt_pk_bf16(d.x * rs * g.x * omli, d.y * rs * g.y * omli);
    }
}

__device__ __forceinline__ void p6_tile(Frame& F, const KA& a, int l, int tile) {
    unsigned char* ws = a.ws();
    constexpr int HS = 4112;
    LAS unsigned char* hT = F.lds; LAS float* LG = (LAS float*)(F.lds + 132096);
    const float* Y = (const float*)(ws + WS_Y); float* X1 = (float*)(ws + WS_X1); bf16* H = (bf16*)(ws + WS_H);
    const float* g1 = a.in(16) + (size_t)l * DM; const float* b1 = a.in(17) + (size_t)l * DM;
    const int row0 = tile * 32; const int b = row0 >> 12;
    const float* ada = (const float*)(ws + WS_ADA) + (size_t)(l * 2 + b) * ADA_W;
    const float* shf = ada + 3 * DM; const float* scf = ada + 4 * DM;
    f32x4 vn[8];
#pragma unroll
    for (int j = 0; j < 8; ++j) vn[j] = __builtin_nontemporal_load((const f32x4*)(Y + (size_t)(row0 + F.wave * 4) * DM + 4 * F.lane + 256 * j));
#pragma unroll 1
    for (int rr = 0; rr < 4; ++rr) {
        const int lr = F.wave * 4 + rr, row = row0 + lr;
        f32x4 v[8];
#pragma unroll
        for (int j = 0; j < 8; ++j) v[j] = vn[j];
        if (rr < 3) {
#pragma unroll
            for (int j = 0; j < 8; ++j) vn[j] = __builtin_nontemporal_load((const f32x4*)(Y + (size_t)(row + 1) * DM + 4 * F.lane + 256 * j));
        }
        float mean, rstd; row_stats(v, mean, rstd);
#pragma unroll
        for (int j = 0; j < 8; ++j) { const f32x4 g = *(const f32x4*)(g1 + 4 * F.lane + 256 * j), bb = *(const f32x4*)(b1 + 4 * F.lane + 256 * j);
            v[j] = (v[j] - mean) * rstd * g + bb; __builtin_nontemporal_store(v[j], (f32x4*)(X1 + (size_t)row * DM + 4 * F.lane + 256 * j)); }
        row_stats(v, mean, rstd);
#pragma unroll
        for (int j = 0; j < 8; ++j) { const f32x4 s1 = *(const f32x4*)(scf + 4 * F.lane + 256 * j) + 1.0f, s0 = *(const f32x4*)(shf + 4 * F.lane + 256 * j);
            const f32x4 y = (v[j] - mean) * rstd * s1 + s0;
            u32x2 w; w.x = cvt_pk_bf16(y.x, y.y); w.y = cvt_pk_bf16(y.z, y.w);
            if (MOE_FP8_LAST && (MOE_FP8_GU_ALL || l == NLAYER - 1)) { int q8 = __builtin_amdgcn_cvt_pk_fp8_f32(clamp8(y.x), clamp8(y.y), 0, false); q8 = __builtin_amdgcn_cvt_pk_fp8_f32(clamp8(y.z), clamp8(y.w), q8, true);
                st_wt4((unsigned char*)H + (size_t)row * DM + 4 * F.lane + 256 * j, (unsigned)q8); }
            else *(u32x2*)(H + (size_t)row * DM + 4 * F.lane + 256 * j) = w;
            *(LAS u32x2*)(hT + lr * HS + (4 * F.lane + 256 * j) * 2) = w; }
    }
    __syncthreads();
    {
        const int mt = F.wave >> 2, nt = F.wave & 3, fr = F.lane & 15, fq = F.lane >> 4;
        const bf16* Wr = (const bf16*)(ws + WS_W + (size_t)l * W_LSTRIDE + W_R) + (size_t)(nt * 16 + fr) * DM + fq * 8;
        const LAS unsigned char* ap = hT + (mt * 16 + fr) * HS + fq * 16;
        f32x4 acc = {0.f, 0.f, 0.f, 0.f};
#pragma unroll 8
        for (int ks = 0; ks < 64; ++ks) { const bf16x8 av = *(const LAS bf16x8*)(ap + ks * 64); const bf16x8 bv = *(const bf16x8*)(Wr + ks * 32);
            acc = __builtin_amdgcn_mfma_f32_16x16x32_bf16(av, bv, acc, 0, 0, 0); }
#pragma unroll
        for (int i = 0; i < 4; ++i) LG[(mt * 16 + fq * 4 + i) * 64 + nt * 16 + fr] = acc[i];
    }
    __syncthreads();
    {
        const float bias = a.in(19)[(size_t)l * 64 + F.lane];
        unsigned* cnt = (unsigned*)(ws + WS_CTL) + CW_CNT + l * 4096;
        int* list = (int*)(ws + WS_LIST); int* tokslot = (int*)(ws + WS_TOKSLOT); float* tokw = (float*)(ws + WS_TOKW);
        int rk[4]; float wq[4]; unsigned ps[4];
#pragma unroll
        for (int rr = 0; rr < 4; ++rr) {
            const int lr = F.wave * 4 + rr;
            const float lg = LG[lr * 64 + F.lane];
            const float sg = 1.f / (1.f + __expf(-lg));
            const float bs = sg + bias;
            float m1 = bs;
#pragma unroll
            for (int o = 1; o < 8; o <<= 1) m1 = fmaxf(m1, shfl_idx(m1, F.lane ^ o));
            const unsigned long long eq = __ballot(bs == m1);
            const int gbase = F.lane & ~7;
            const unsigned gm = (unsigned)((eq >> gbase) & 0xffull);
            const int first = gbase + __builtin_ctz(gm);
            float m2 = (F.lane == first) ? -__builtin_huge_valf() : bs;
#pragma unroll
            for (int o = 1; o < 8; o <<= 1) m2 = fmaxf(m2, shfl_idx(m2, F.lane ^ o));
            const float gs = m1 + m2; const int g = F.lane >> 3;
            int grank = 0;
#pragma unroll
            for (int q = 0; q < 8; ++q) { const float og = shfl_idx(gs, q * 8); grank += (og > gs || (og == gs && q < g)) ? 1 : 0; }
            const float val = (grank < 4) ? bs : -__builtin_huge_valf();
            int rank = 0;
#pragma unroll 8
            for (int q = 0; q < 64; ++q) { const float ov = shfl_idx(val, q); rank += (ov > val || (ov == val && q < F.lane)) ? 1 : 0; }
            const bool sel = rank < 8;
            const float wsum = wave_sum(sel ? sg : 0.f);
            rk[rr] = sel ? rank : -1; wq[rr] = sg / wsum * 2.5f;
        }
#pragma unroll
        for (int rr = 0; rr < 4; ++rr) ps[rr] = (rk[rr] >= 0) ? atomicAdd(cnt + 64 * F.lane, 1u) : 0u;
#pragma unroll
        for (int rr = 0; rr < 4; ++rr) if (rk[rr] >= 0) { const int tok = row0 + F.wave * 4 + rr;
            list[F.lane * 8192 + ps[rr]] = tok;
            tokslot[tok * 8 + rk[rr]] = (F.lane << 16) | (int)ps[rr];
            tokw[tok * 8 + rk[rr]] = wq[rr]; }
    }
    __syncthreads();
}

__device__ __forceinline__ void moe_tables(Frame& F, const KA& a, int l, LAS int* pref, LAS int* cntL) {
    const unsigned* cnt = (const unsigned*)(a.ws() + WS_CTL) + CW_CNT + l * 4096;
    if (F.tid < 64) cntL[F.tid] = (int)__hip_atomic_load(cnt + 64 * F.tid, RLX_AGENT);
    if (F.tid == 64) cntL[64] = NTOK;
    __syncthreads();
    if (F.tid < 64) {
        const int nt_e = (cntL[F.tid] + 255) >> 8; int inc = nt_e;
#pragma unroll
        for (int o = 1; o < 64; o <<= 1) { const int up = __builtin_amdgcn_ds_bpermute(((F.tid - o) & 63) << 2, inc); if (F.tid >= o) inc += up; }
        pref[F.tid] = inc - nt_e;
        if (F.tid == 63) { pref[64] = inc; pref[NE1] = inc + (NTOK >> 8); }
    }
    __syncthreads();
    if (F.tid < NE1) { const int t0 = pref[F.tid], t1 = pref[F.tid + 1]; for (int t = t0; t < t1; ++t) pref[400 + t] = F.tid; }
    __syncthreads();
}

__device__ __forceinline__ void p9_row(const KA& a, int l, int row, const LAS int* pref, int lane, int ts_l, float w_l) {
    unsigned char* ws = a.ws();
    const unsigned char* YS = ws + WS_YS; const float* X1 = (const float*)(ws + WS_X1);
    const int b = row >> 12;
    const float* ada = (const float*)(ws + WS_ADA) + (size_t)(l * 2 + b) * ADA_W;
    const float* gf = ada + 5 * DM;
    f32x4 m[8];
#pragma unroll
    for (int j = 0; j < 8; ++j) m[j] = (f32x4){0.f, 0.f, 0.f, 0.f};
    int slot_l = (lane < 8) ? pref[ts_l >> 16] * 256 + (ts_l & 0xffff) : pref[64] * 256 + row;
    if (lane >= 8) w_l = 1.f;
    w_l *= (1.f / YS_SCALE);
    const __amdgpu_buffer_rsrc_t yrs = __builtin_amdgcn_make_buffer_rsrc((void*)YS, 0, (unsigned)((size_t)SLOT_MAX * DM), 0x00020000);
    const int voff = 4 * lane;
    int yv[8][8], ys[8];
#pragma unroll
    for (int k = 0; k < 8; ++k) { const int soff = __builtin_amdgcn_readlane(slot_l, k) * DM;
#pragma unroll
        for (int j = 0; j < 8; ++j) yv[k][j] = __builtin_amdgcn_raw_buffer_load_b32(yrs, voff + 256 * j, soff, 2); }
#pragma unroll
    for (int k = 0; k < 8; ++k) { const float w = __builtin_bit_cast(float, __builtin_amdgcn_readlane(__builtin_bit_cast(int, w_l), k));
        if (k == 0) { const int soff = __builtin_amdgcn_readlane(slot_l, 8) * DM;
#pragma unroll
            for (int j = 0; j < 8; ++j) ys[j] = __builtin_amdgcn_raw_buffer_load_b32(yrs, voff + 256 * j, soff, 2); }
#pragma unroll
        for (int j = 0; j < 8; ++j) { const f32x2 lo = __builtin_amdgcn_cvt_pk_f32_fp8(yv[k][j], false), hi = __builtin_amdgcn_cvt_pk_f32_fp8(yv[k][j], true);
            m[j].x = fmaf(w, lo.x, m[j].x); m[j].y = fmaf(w, lo.y, m[j].y); m[j].z = fmaf(w, hi.x, m[j].z); m[j].w = fmaf(w, hi.y, m[j].w); } }
    { const float w = 1.f / YS_SCALE;
#pragma unroll
        for (int j = 0; j < 8; ++j) { const f32x2 lo = __builtin_amdgcn_cvt_pk_f32_fp8(ys[j], false), hi = __builtin_amdgcn_cvt_pk_f32_fp8(ys[j], true);
            m[j].x = fmaf(w, lo.x, m[j].x); m[j].y = fmaf(w, lo.y, m[j].y); m[j].z = fmaf(w, hi.x, m[j].z); m[j].w = fmaf(w, hi.y, m[j].w); } }
    asm volatile("" ::: "memory");
    f32x4 v[8];
#pragma unroll
    for (int j = 0; j < 8; ++j) { const f32x4 x1 = __builtin_nontemporal_load((const f32x4*)(X1 + (size_t)row * DM + 4 * lane + 256 * j)), g = *(const f32x4*)(gf + 4 * lane + 256 * j) + 1.0f;
        v[j] = x1 * DN_ALPHA + g * m[j]; }
    float mean, rstd; row_stats(v, mean, rstd);
    const float* g2 = a.in(26) + (size_t)l * DM; const float* b2 = a.in(27) + (size_t)l * DM;
    asm volatile("" ::: "memory");
#pragma unroll
    for (int j = 0; j < 8; ++j) { const f32x4 g = *(const f32x4*)(g2 + 4 * lane + 256 * j), bb = *(const f32x4*)(b2 + 4 * lane + 256 * j);
        v[j] = (v[j] - mean) * rstd * g + bb; st_wt16(a.out() + (size_t)row * DM + 4 * lane + 256 * j, __builtin_bit_cast(u32x4, v[j])); }
    asm volatile("" ::: "memory");
    if (l + 1 < NLAYER) {
        const float* ada2 = (const float*)(ws + WS_ADA) + (size_t)((l + 1) * 2 + b) * ADA_W;
        row_stats(v, mean, rstd);
        bf16* hrow = (bf16*)(ws + WS_H) + (size_t)row * DM;
#pragma unroll
        for (int j = 0; j < 8; ++j) { const f32x4 s1 = *(const f32x4*)(ada2 + DM + 4 * lane + 256 * j) + 1.0f, s0 = *(const f32x4*)(ada2 + 4 * lane + 256 * j);
            const f32x4 y = (v[j] - mean) * rstd * s1 + s0;
            u32x2 w; w.x = cvt_pk_bf16(y.x, y.y); w.y = cvt_pk_bf16(y.z, y.w); st_wt8(hrow + 4 * lane + 256 * j, w); }
    }
}

__device__ __forceinline__ Frame make_frame(unsigned char* ws) {
    extern __shared__ __attribute__((aligned(16))) unsigned char lds_raw[];
    Frame F;
    F.lds = (LAS unsigned char*)lds_raw;
    F.MISC = (volatile LAS unsigned*)(F.lds + MISC_OFF);
    int t = tid_x(); asm volatile("" : "+v"(t));
    F.tid = t; F.lane = t & 63; F.wave = __builtin_amdgcn_readfirstlane(t >> 6);
    F.G = gridDim.x; F.gw = blockIdx.x * 8 + F.wave; F.NGW = F.G * 8;
    F.ctl = (unsigned*)(ws + WS_CTL);
    return F;
}

__global__ void __launch_bounds__(512, 2) mk_fwd(Args args) {
    extern __shared__ __attribute__((aligned(16))) unsigned char lds_raw[];
    XcdBarrier bar;
    int lo, hi;
    {
        const KA a = fresh_ka(); unsigned char* ws = a.ws();
        LAS unsigned char* lds = (LAS unsigned char*)lds_raw;
        for (int u = threadIdx.x; u < 128; u += 512) ((LAS unsigned*)(lds + MISC_OFF))[u] = 0u;
        __syncthreads();
        if ((threadIdx.x & 63) == 0) ((LAS int*)(lds + MISC_OFF))[64 + hw_wave_slot()] = (int)(threadIdx.x >> 6);
        __syncthreads();
        unsigned* ctl = (unsigned*)(ws + WS_CTL);
        bar.bar = ctl + CW_BAR; bar.x = 0; bar.st = (volatile LAS unsigned*)(lds + MISC_OFF) + 8;
        if (!MK_PER_PHASE) bar = xcd_barrier_post(ctl + CW_BAR, (volatile LAS unsigned*)(lds + MISC_OFF) + 8);
        lo = a.ph_lo(); hi = a.ph_hi();
    }
#ifndef PHMASK
#define PHMASK 0xFFFFu
#endif
#define PT(t) (((PHMASK) >> (t)) & 1u)
#define IN(k) (lo <= (k) && (k) < hi)
#define SEAM(k) do { if (!MK_PER_PHASE && (k) + 1 < hi) xcd_barrier_work(bar, a, ws, F.lds); } while (0)
#define PHASE_BEGIN() const KA a = fresh_ka(); unsigned char* ws = a.ws(); Frame F = make_frame(ws); (void)F

    if (PT(0) && IN(0)) { PHASE_BEGIN(); p0_prologue(F, a); SEAM(0); }
    if (PT(1) && IN(1)) {
        PHASE_BEGIN();
        const float* ADA = (const float*)(ws + WS_ADA); bf16* H = (bf16*)(ws + WS_H); const float* x = a.in(0);
        for (int row = F.gw; row < NTOK; row += F.NGW) { const float* ada = ADA + (size_t)(row >> 12) * ADA_W;
            ln_mod_row(x + (size_t)row * DM, ada, ada + DM, H + (size_t)row * DM, F.lane); }
        SEAM(1);
    }
#pragma unroll 1
    for (int l = 0; l < NLAYER; ++l) {
        const int pb = 2 + 8 * l;
        if (PT(2) && IN(pb + 0)) {
            PHASE_BEGIN(); unsigned char* wl = ws + WS_W + (size_t)l * W_LSTRIDE;
            pg8::DenseSched S; S.init(ws + WS_H, DM, wl + W_IN, NTOK, UW, DM, F.G, (int)blockIdx.x);
            pg8::EpiBf16 E{(bf16*)(ws + WS_U), UW};
            pg8::gemm_phase<GEMM_SP2, true>(F.lds, S, E, DM);
            SEAM(pb + 0);
        }
        if (PT(3) && IN(pb + 1)) {
            PHASE_BEGIN(); bf16* U = (bf16*)(ws + WS_U);
            const float* gq = a.in(5) + (size_t)l * 512; const float* gkv = a.in(7) + (size_t)l * 256;
            for (int row = F.gw; row < NTOK; row += F.NGW)
                post_u_row(U + (size_t)row * UW, row & (SEQ - 1), gq, gkv, (const f32x2*)(ws + WS_ROPEM), (const f32x2*)(ws + WS_ROPED), F.lane);
            SEAM(pb + 1);
        }
        if (PT(4) && IN(pb + 2)) {
            PHASE_BEGIN(); unsigned char* wl = ws + WS_W + (size_t)l * W_LSTRIDE; bf16* U = (bf16*)(ws + WS_U);
            const bool has_na = (((int)blockIdx.x >> 3) & 1) == 0 || F.G != 256;
            { pg8::DenseSched S;
              if (F.G == 256) S.init(U + U_CQ, UW, wl + W_UQ, NTOK, QMW, 512, 128, has_na ? (1 << 20) : (int)((blockIdx.x & 7) + 8 * (blockIdx.x >> 4)));
              else S.init(U + U_CQ, UW, wl + W_UQ, NTOK, QMW, 512, F.G, (int)blockIdx.x);
              pg8::EpiBf16 E{(bf16*)(ws + WS_QM), QMW}; pg8::gemm_phase<GEMM_SP2, false>(F.lds, S, E, 512); }
            { pg8::DenseSched S; S.init(U + U_CKV, UW, wl + W_UKV, NTOK, KVW, 256, F.G, (int)blockIdx.x);
              pg8::EpiBf16 E{(bf16*)(ws + WS_KVM), KVW}; pg8::gemm_phase<GEMM_SP2, false>(F.lds, S, E, 256); }
            {
                att::AttnP P; P.U = (const bf16*)(ws + WS_U); P.QM = (const bf16*)(ws + WS_QM); P.KVM = (const bf16*)(ws + WS_KVM); P.MIX = (bf16*)(ws + WS_MIX);
                P.O1 = (float*)(ws + WS_O1); P.O2 = (float*)(ws + WS_O2); P.ropeM = (const f32x2*)(ws + WS_ROPEM); P.rpb = a.in(9) + (size_t)l * 4 * 465;
                LAS char* al = (LAS char*)F.lds;
                for (int c = blockIdx.x; c < 256; c += F.G) {
                    const int xcd = c & 7, j = c >> 3;
                    const int du = (xcd * 16 + (j & 15));
                    if (j >> 4) att::attn_unit<att::MODE_DIFF, 1>(P, du, al); else att::attn_unit<att::MODE_DIFF, 0>(P, du, al);
                    if (!(j & 1)) att::attn_unit<att::MODE_NA>(P, xcd * 16 + (j >> 1), al);
                }
            }
            SEAM(pb + 2);
        }
        if (PT(5) && IN(pb + 3)) {
            PHASE_BEGIN();
            att::AttnP P; P.U = (const bf16*)(ws + WS_U); P.QM = (const bf16*)(ws + WS_QM); P.KVM = (const bf16*)(ws + WS_KVM); P.MIX = (bf16*)(ws + WS_MIX);
            P.O1 = (float*)(ws + WS_O1); P.O2 = (float*)(ws + WS_O2); P.ropeM = (const f32x2*)(ws + WS_ROPEM);
            P.rpb = a.in(9) + (size_t)l * 4 * 465;
            LAS char* al = (LAS char*)F.lds;
#ifndef ATT_MASK
#define ATT_MASK 7
#endif
            {
                const float lam_init = (l == 0) ? 0.2f : 0.35550906759096934f;
                const float la = a.in(10)[l * 64 + F.lane] * a.in(11)[l * 64 + F.lane], lb = a.in(12)[l * 64 + F.lane] * a.in(13)[l * 64 + F.lane];
                const float lam = __expf(wave_sum(la)) - __expf(wave_sum(lb)) + lam_init;
                const float* o1 = (const float*)(ws + WS_O1); const float* o2 = (const float*)(ws + WS_O2); bf16* MIXp = (bf16*)(ws + WS_MIX);
                for (int row = F.gw; row < NTOK; row += F.NGW)
                    diff_combine_row(o1 + (size_t)row * 512, o2 + (size_t)row * 512, MIXp + (size_t)row * DM, lam, a.in(14) + l * 128, 1.0f - lam_init, F.lane);
                __syncthreads();
            }
            const bool conv_first = ((blockIdx.x >> 3) & 1) != 0;
            if (conv_first) conv_drain(a, ws, F.lds, (l + 1) * Q_PER_L, CONV_QUOTA);
            for (int c = blockIdx.x; c < 256; c += F.G) {
                const int xcd = c & 7, j = c >> 3;
                if (ATT_MASK & 1) att::attn_unit<att::MODE_MLA>(P, (xcd * 2 + (j >> 4)) * 16 + (j & 15), al);
            }
            if (!conv_first) conv_drain(a, ws, F.lds, (l + 1) * Q_PER_L, CONV_QUOTA);
            SEAM(pb + 3);
        }
        if (PT(6) && IN(pb + 4)) {
            PHASE_BEGIN(); unsigned char* wl = ws + WS_W + (size_t)l * W_LSTRIDE;
            const float* xin = (l == 0) ? a.in(0) : (const float*)a.out();
            pg8::DenseSched S; S.init(ws + WS_MIX, DM, wl + W_O, NTOK, DM, DM, F.G, (int)blockIdx.x);
            pg8::EpiResid E{xin, (const float*)(ws + WS_ADA) + (size_t)(l * 2) * ADA_W + 2 * DM, (float*)(ws + WS_Y)};
            pg8::gemm_phase<GEMM_SP2, false>(F.lds, S, E, DM);
            SEAM(pb + 4);
        }
        if (PT(7) && IN(pb + 5)) {
            PHASE_BEGIN();
            for (int t = blockIdx.x; t < NTOK / 32; t += F.G) p6_tile(F, a, l, t);
            conv_drain(a, ws, F.lds, (l + 1) * Q_PER_L);
            SEAM(pb + 5);
        }
        if (PT(8) && IN(pb + 6)) {
            PHASE_BEGIN(); unsigned char* wl = ws + WS_W + (size_t)l * W_LSTRIDE;
            LAS int* pref = (LAS int*)(F.lds + EXTRA_OFF); LAS int* cntL = pref + 80;
            moe_tables(F, a, l, pref, cntL);
            unsigned* ready = F.ctl + CW_MT + l * 32768;
            const int tgu = pref[NE1] * 4;
            const int moe_c = (MOE_CHUNK && (F.G & 7) == 0) ? (int)((blockIdx.x & 7u) * (unsigned)(F.G >> 3) + (blockIdx.x >> 3)) : (int)blockIdx.x;
            const bool f8 = MOE_FP8_LAST && (MOE_FP8_GU_ALL || l == NLAYER - 1);
            const bool f8d = f8 || (MOE_FP8_LAST && MOE_FP8_DOWN_ALL);
            {
                pg8::MoeGUSched S; S.Hb = (const char*)(ws + WS_H); S.W = (const char*)(wl + W_GU); S.list = (const int*)(ws + WS_LIST); S.pref = pref; S.cnt = cntL;
                S.total = tgu; S.G = F.G; S.c = moe_c; S.rowB = f8 ? DM : DM * 2;
                if (f8) { pg8::EpiGateUpT<true> E{(bf16*)(ws + WS_ACT), ready}; pg8::gemm_phase<GEMM_SP2, true, true>(F.lds, S, E, DM / 2, 121, 127); }
                else if (f8d) { pg8::EpiGateUpT<true> E{(bf16*)(ws + WS_ACT), ready}; pg8::gemm_phase<GEMM_SP2, true>(F.lds, S, E, DM); }
                else { pg8::EpiGateUp E{(bf16*)(ws + WS_ACT), ready}; pg8::gemm_phase<GEMM_SP2, true>(F.lds, S, E, DM); }
            }
            {
                pg8::MoeDownSched S; S.Act = (const char*)(ws + WS_ACT); S.W = (const char*)(wl + W_D); S.pref = pref; S.total = pref[NE1] * 8; S.G = F.G;
                const int n6r = tgu % F.G; S.c = (int)((moe_c + F.G - n6r) % F.G);
                if (DOWN_LEAD > 0 && n6r > 0) { S.n6 = n6r; S.lead = (moe_c >= n6r) ? 1 : 0; }
                else { S.n6 = F.G; S.lead = 0; }
                S.ready = ready; S.tmo = F.ctl + CW_TMO; S.rowB = f8d ? FFE : FFE * 2;
                pg8::EpiFp8 E{ws + WS_YS, DM, YS_SCALE};
                if (f8d) pg8::gemm_phase<GEMM_SP2, true, true>(F.lds, S, E, FFE / 2, 121, 125);
                else pg8::gemm_phase<GEMM_SP2, true>(F.lds, S, E, FFE);
            }
            SEAM(pb + 6);
        }
        if (PT(10) && IN(pb + 7)) {
            PHASE_BEGIN();
            LAS int* pref = (LAS int*)(F.lds + EXTRA_OFF); LAS int* cntL = pref + 80;
            moe_tables(F, a, l, pref, cntL);
            {
                const int* tokslot = (const int*)(ws + WS_TOKSLOT); const float* tokw = (const float*)(ws + WS_TOKW);
                int t = 0; float w = 0.f;
                if (F.lane < 8 && F.gw < NTOK) { t = tokslot[F.gw * 8 + F.lane]; w = tokw[F.gw * 8 + F.lane]; }
#pragma unroll 1
                for (int row = F.gw; row < NTOK; row += F.NGW) { int tn = 0; float wn = 0.f; const int nr = row + F.NGW;
                    if (F.lane < 8 && nr < NTOK) { tn = tokslot[nr * 8 + F.lane]; wn = tokw[nr * 8 + F.lane]; }
                    p9_row(a, l, row, pref, F.lane, t, w); t = tn; w = wn; }
            }
            SEAM(pb + 7);
        }
    }
#undef IN
#undef SEAM
}

extern "C" void kernel_launch(void* const* d_in, const int* in_sizes, int n_in, void* d_out, int out_size, void* d_ws, size_t ws_size, hipStream_t stream) {
    static int grid = 0;
    if (grid == 0) {
        if (n_in != 28 || out_size != NTOK * DM || ws_size < WS_END) { fprintf(stderr, "kernel_launch: unexpected shapes: n_in %d out %d ws %zu (need %zu)\n", n_in, out_size, ws_size, (size_t)WS_END); grid = -1; return; }
        int dev = 0, cus = 0, per_cu = 0;
        if (hipGetDevice(&dev) != hipSuccess || hipDeviceGetAttribute(&cus, hipDeviceAttributeMultiprocessorCount, dev) != hipSuccess) { grid = -1; return; }
        if (hipFuncSetAttribute((const void*)mk_fwd, hipFuncAttributeMaxDynamicSharedMemorySize, LDS_BYTES) != hipSuccess) { fprintf(stderr, "kernel_launch: hipFuncSetAttribute failed\n"); grid = -1; return; }
        if (hipOccupancyMaxActiveBlocksPerMultiprocessor(&per_cu, (const void*)mk_fwd, 512, LDS_BYTES) != hipSuccess || per_cu < 1) { fprintf(stderr, "kernel_launch: occupancy query says %d\n", per_cu); }
        (void)hipGetLastError();
        grid = cus;
    }
    if (grid < 0) return;
    (void)hipMemsetAsync((char*)d_ws + WS_CTL, 0, CTL_ZERO_BYTES, stream);
    Args a{};
    for (int i = 0; i < 28; ++i) a.in[i] = (const float*)d_in[i];
    a.out = (float*)d_out; a.ws = (unsigned char*)d_ws;
#if MK_PER_PHASE
    for (int p = 0; p < NPHASE; ++p) { a.ph_lo = p; a.ph_hi = p + 1; hipLaunchKernelGGL(mk_fwd, dim3(grid), dim3(512), LDS_BYTES, stream, a); }
#else
    a.ph_lo = 0; a.ph_hi = NPHASE;
    hipLaunchKernelGGL(mk_fwd, dim3(grid), dim3(512), LDS_BYTES, stream, a);
#endif
    const hipError_t le = hipPeekAtLastError();
    if (le != hipSuccess) fprintf(stderr, "kernel_launch: launch failed: %s\n", hipGetErrorName(le));
}
```

```cpp
#include <hip/hip_runtime.h>
#include <cstdio>
#include <cstdint>

#ifndef MK_PER_PHASE
#define MK_PER_PHASE 0
#endif

#define LAS __attribute__((address_space(3)))
#define GAS __attribute__((address_space(1)))
typedef unsigned short bf16;
typedef short bf16x8 __attribute__((ext_vector_type(8)));
typedef short s16x4 __attribute__((ext_vector_type(4)));
typedef float f32x2 __attribute__((ext_vector_type(2)));
typedef float f32x4 __attribute__((ext_vector_type(4)));
typedef float f32x16 __attribute__((ext_vector_type(16)));
typedef unsigned u32x2 __attribute__((ext_vector_type(2)));
typedef unsigned u32x4 __attribute__((ext_vector_type(4)));

constexpr int NTOK = 8192, SEQ = 4096, DM = 2048, NLAYER = 2;
constexpr int UW = 4096;
constexpr int U_CQ = 0, U_CKV = 512, U_KR = 768, U_NA = 1024, U_DF = 2560;
constexpr int QMW = 1536, KVW = 2048;
constexpr int NEXP = 64, FFE = 512, NE1 = 65;
constexpr int SLOT_MAX = 90112;
constexpr float DN_ALPHA = 1.4142135623730951f;
constexpr float LN_EPS = 1e-5f, RMS_EPS = 1e-6f;
constexpr int ADA_W = 6 * DM;
constexpr float YS_SCALE = 16.f;
#ifndef MOE_FP8_LAST
#ifndef DOWN_LEAD
#define DOWN_LEAD 4
#endif
#ifndef MOE_CHUNK
#define MOE_CHUNK 1
#endif
#define MOE_FP8_LAST 1
#endif
#ifndef MOE_FP8_GU_ALL
#define MOE_FP8_GU_ALL 1
#endif
#ifndef MOE_FP8_DOWN_ALL
#define MOE_FP8_DOWN_ALL 1
#endif
constexpr float W8_SCALE = 64.f, ACT8_SCALE = 4.f;
__device__ __forceinline__ float clamp8(float x) { return __builtin_amdgcn_fmed3f(x, -448.f, 448.f); }

constexpr size_t MiB = 1u << 20;
constexpr size_t WS_CTL = 0, CTL_ZERO_BYTES = 1 * MiB;
constexpr size_t WS_ADA = 1 * MiB;
constexpr size_t WS_ROPEM = 2 * MiB;
constexpr size_t WS_ROPED = 3 * MiB;
constexpr size_t WS_LIST = 4 * MiB;
constexpr size_t WS_TOKSLOT = 6 * MiB;
constexpr size_t WS_TOKW = 6 * MiB + 512 * 1024;
constexpr size_t WS_H = 8 * MiB;
constexpr size_t WS_U = 40 * MiB;
constexpr size_t WS_QM = 104 * MiB;
constexpr size_t WS_KVM = 128 * MiB;
constexpr size_t WS_MIX = 160 * MiB;
constexpr size_t WS_O1 = 192 * MiB;
constexpr size_t WS_O2 = 784 * MiB;
constexpr size_t WS_Y = 208 * MiB;
constexpr size_t WS_X1 = 272 * MiB;
constexpr size_t WS_ACT = 336 * MiB;
constexpr size_t WS_YS = 432 * MiB;
constexpr size_t WS_W = 800 * MiB, W_LSTRIDE = 424 * MiB;
constexpr size_t W_IN = 0, W_UQ = 16 * MiB, W_UKV = 18 * MiB, W_O = 20 * MiB, W_R = 28 * MiB, W_GU = 32 * MiB, W_D = 292 * MiB;
constexpr size_t WS_END = WS_W + 2 * W_LSTRIDE;
static_assert(WS_ACT + (size_t)SLOT_MAX * 512 * 2 <= WS_YS && WS_YS + (size_t)SLOT_MAX * 2048 * 2 <= WS_O2 && WS_O2 + 16 * MiB <= WS_W, "ws map");
static_assert(W_GU + (size_t)NE1 * 1024 * 2048 * 2 <= W_D && W_D + (size_t)NE1 * 2048 * 512 * 2 <= W_LSTRIDE, "w map");
constexpr int CW_TMO = 0, CW_BAR = 4096, CW_CNT = 16384;
constexpr int CW_MT = 65536;

constexpr int LDS_BYTES = 147456;
constexpr int RING_BYTES = 131072;
constexpr int EXTRA_OFF = 131072;
constexpr int MISC_OFF = LDS_BYTES - 512;

#define RLX_AGENT __ATOMIC_RELAXED, __HIP_MEMORY_SCOPE_AGENT
#define LDS_WAIT() asm volatile("s_waitcnt lgkmcnt(0)" ::: "memory")
#define VM_WAIT() asm volatile("s_waitcnt vmcnt(0)" ::: "memory")

__device__ __forceinline__ unsigned cvt_pk_bf16(float lo, float hi) { unsigned r; asm volatile("v_cvt_pk_bf16_f32 %0, %1, %2" : "=v"(r) : "v"(lo), "v"(hi)); return r; }
__device__ __forceinline__ float bf2f(unsigned short b) { return __builtin_bit_cast(float, (unsigned)b << 16); }
__device__ __forceinline__ float bflo(unsigned w) { return __builtin_bit_cast(float, w << 16); }
__device__ __forceinline__ float bfhi(unsigned w) { return __builtin_bit_cast(float, w & 0xffff0000u); }
__device__ __forceinline__ float ldg_f32(const void* b, unsigned off) { return *(const float*)((const char*)b + off); }
#ifndef WT_STORES
#define WT_STORES 1
#endif
__device__ __forceinline__ void st_wt16(void* p, u32x4 v) { if (WT_STORES) asm volatile("global_store_dwordx4 %0, %1, off sc1\n\ts_nop 1" :: "v"(p), "v"(v) : "memory"); else *(u32x4*)p = v; }
__device__ __forceinline__ void st_wt8(void* p, u32x2 v) { if (WT_STORES) asm volatile("global_store_dwordx2 %0, %1, off sc1" :: "v"(p), "v"(v) : "memory"); else *(u32x2*)p = v; }
__device__ __forceinline__ void st_wt4(void* p, unsigned v) { if (WT_STORES) asm volatile("global_store_dword %0, %1, off sc1" :: "v"(p), "v"(v) : "memory"); else *(unsigned*)p = v; }
__device__ __forceinline__ void stg_f32(void* b, unsigned off, float v) { *(float*)((char*)b + off) = v; }
__device__ __forceinline__ void stg_u16(void* b, unsigned off, unsigned short v) { *(unsigned short*)((char*)b + off) = v; }
__device__ __forceinline__ bf16x8 ldg_b128(const void* b, unsigned off) { return *(const bf16x8*)((const char*)b + off); }
__device__ __forceinline__ int hw_wave_slot() { return (int)(__builtin_amdgcn_s_getreg((5 << 11) | 4) & 63u); }
__device__ __forceinline__ int tid_x() {
    extern __shared__ __attribute__((aligned(16))) unsigned char lds_raw_t[];
    const int w = ((volatile LAS int*)((LAS unsigned char*)lds_raw_t + MISC_OFF))[64 + hw_wave_slot()];
    int l; asm volatile("v_mbcnt_lo_u32_b32 %0, -1, 0\n\tv_mbcnt_hi_u32_b32 %0, -1, %0" : "=v"(l));
    return __builtin_amdgcn_readfirstlane(w) * 64 + l;
}
__device__ __forceinline__ int lane_id_local() { int l; asm volatile("v_mbcnt_lo_u32_b32 %0, -1, 0\n\tv_mbcnt_hi_u32_b32 %0, -1, %0" : "=v"(l)); return l; }
__device__ __forceinline__ float shfl_idx(float v, int src) { return __builtin_bit_cast(float, __builtin_amdgcn_ds_bpermute(src << 2, __builtin_bit_cast(int, v))); }
#ifndef WSUM_DPP
#define WSUM_DPP 1
#endif
__device__ __forceinline__ float wave_sum(float v) {
#if WSUM_DPP
#define WS_STEP(ctrl, rmask) v += __builtin_bit_cast(float, __builtin_amdgcn_update_dpp(0, __builtin_bit_cast(int, v), ctrl, rmask, 0xf, false))
    WS_STEP(0x111, 0xf); WS_STEP(0x112, 0xf); WS_STEP(0x114, 0xf); WS_STEP(0x118, 0xf);
    WS_STEP(0x142, 0xa); WS_STEP(0x143, 0xc);
#undef WS_STEP
    return __builtin_bit_cast(float, __builtin_amdgcn_readlane(__builtin_bit_cast(int, v), 63));
#else
    const int l = lane_id_local();
#pragma unroll
    for (int o = 1; o < 64; o <<= 1) v += shfl_idx(v, l ^ o);
    return v;
#endif
}

#define XB_TMO      128
#define XB_XCNT(j)  (256  + 64 * (j))
#define XB_XSUB(j)  (1280 + 64 * (j))
#define XB_XGEN(j)  (2304 + 64 * (j))
#define XB_TOP      3328
#define XB_TOPGEN   3392
#define XCD_BAR_WORDS 3456
#define XB_SPIN_CAP (1u << 22)

__device__ __forceinline__ unsigned xb_ld(unsigned* p)              { return __hip_atomic_load(p, __ATOMIC_RELAXED, __HIP_MEMORY_SCOPE_AGENT); }
__device__ __forceinline__ unsigned xb_add(unsigned* p, unsigned v) { return __hip_atomic_fetch_add(p, v, __ATOMIC_RELAXED, __HIP_MEMORY_SCOPE_AGENT); }
__device__ __forceinline__ unsigned xb_xcc_id() { return (unsigned)__builtin_amdgcn_s_getreg((3 << 11) | 20) & 0xFu; }
#define XB_SPIN(cond, bar) do { unsigned _sp = 0; while (cond) { __builtin_amdgcn_s_sleep(1); \
    if ((++_sp & 255u) == 0u) { if (xb_ld(&(bar)[XB_TMO])) break; if (_sp > XB_SPIN_CAP) { atomicAdd(&(bar)[XB_TMO], 1u); break; } } } } while (0)

struct XcdBarrier { unsigned* bar; unsigned x; volatile LAS unsigned* st; };

__device__ __forceinline__ XcdBarrier xcd_barrier_post(unsigned* bar, volatile LAS unsigned* st) {
    XcdBarrier b; b.bar = bar; b.x = xb_xcc_id(); b.st = st;
    if (tid_x() == 0) (void)xb_add(&bar[XB_XCNT(b.x)], 1u);
    return b;
}
__device__ __forceinline__ void xcd_barrier_complete(unsigned* bar, unsigned x, unsigned& nloc, unsigned& nx) {
    const unsigned G = gridDim.x * gridDim.y * gridDim.z;
    unsigned sum, cnt, mine, sp = 0u;
    for (;;) {
        sum = 0u; cnt = 0u; mine = 0u;
#pragma unroll
        for (unsigned j = 0; j < 16; ++j) { const unsigned c = xb_ld(&bar[XB_XCNT(j)]); sum += c; cnt += (c > 0u) ? 1u : 0u; }
        if (sum == G) break;
        __builtin_amdgcn_s_sleep(1);
        if ((++sp & 255u) == 0u) { if (xb_ld(&bar[XB_TMO])) break; if (sp > XB_SPIN_CAP) { atomicAdd(&bar[XB_TMO], 1u); break; } }
    }
    mine = xb_ld(&bar[XB_XCNT(x)]);
    nloc = mine > 0u ? mine : 1u; nx = cnt > 0u ? cnt : 1u;
}
__device__ __forceinline__ void xcd_barrier(const XcdBarrier& b) {
    asm volatile("s_waitcnt vmcnt(0)" ::: "memory");
    __syncthreads();
    if (tid_x() == 0) {
        unsigned* bar = b.bar;
        __builtin_amdgcn_s_waitcnt(0);
        unsigned nloc = b.st[0], nx = b.st[1];
        if (nloc == 0u) { xcd_barrier_complete(bar, b.x, nloc, nx); b.st[0] = nloc; b.st[1] = nx; }
        const unsigned old = xb_add(&bar[XB_XSUB(b.x)], 1u);
        const unsigned gen = old / nloc;
        if (old + 1u == (gen + 1u) * nloc) {
            __builtin_amdgcn_fence(__ATOMIC_RELEASE, "agent");
            asm volatile("s_waitcnt vmcnt(0)" ::: "memory");
            const unsigned og = xb_add(&bar[XB_TOP], 1u);
            const unsigned tg = og / nx;
            if (og + 1u == (tg + 1u) * nx) xb_add(&bar[XB_TOPGEN], 1u);
            else XB_SPIN(xb_ld(&bar[XB_TOPGEN]) == tg, bar);
            __builtin_amdgcn_fence(__ATOMIC_ACQUIRE, "agent");
            xb_add(&bar[XB_XGEN(b.x)], 1u);
            asm volatile("s_waitcnt vmcnt(0)" ::: "memory");
        } else {
            XB_SPIN(xb_ld(&bar[XB_XGEN(b.x)]) == gen, bar);
            __builtin_amdgcn_fence(__ATOMIC_ACQUIRE, "agent");
            asm volatile("s_waitcnt vmcnt(0)" ::: "memory");
        }
    }
    __syncthreads();
}

namespace pg8 {
constexpr int BM = 256, BK = 64, HALF = 128, HTB = HALF * BK * 2, STAGE_BYTES = 8 * HTB;
__host__ __device__ __forceinline__ int lds_byte(int r, int c) { const int st = (r >> 4) * 2 + (c >> 5), rr = r & 15, cc = c & 31, ob = rr * 64 + cc * 2; return st * 1024 + (ob ^ (((ob >> 9) & 1) << 5)); }
__host__ __device__ __forceinline__ void stage_rc(int b, int& R, int& C) { const int st = b / 1024, sb = b % 1024, swz = sb ^ (((sb >> 9) & 1) << 5); R = (st >> 1) * 16 + swz / 64; C = (st & 1) * 32 + (swz % 64) / 2; }
__host__ __device__ __forceinline__ int perm32(int rho) { const int n = rho >> 4, i = rho & 15; return 8 * (i >> 2) + 4 * n + (i & 3); }

typedef int v8i32 __attribute__((ext_vector_type(8)));
struct Frag2 { bf16x8 lo, hi; };
template <bool SP2, bool ALIGN_EPI, bool FP8 = false, class Epi, class Sched>
__device__ __forceinline__ void gemm_phase(LAS unsigned char* lds, const Sched& S, const Epi& E, const int K, const int s1 = 127, const int s2 = 127) {
    int tid = tid_x(); asm volatile("" : "+v"(tid));
    int s1v = s1, s2v = s2; asm volatile("" : "+v"(s1v), "+v"(s2v));
    const int wid = __builtin_amdgcn_readfirstlane(tid >> 6), lane = tid & 63, wr = wid >> 2, wc = wid & 3, fr = lane & 15, fq = lane >> 4;
    const int nt = K / BK;
    unsigned voffB[2];
#pragma unroll
    for (int i = 0; i < 2; ++i) { int R, C; stage_rc(tid * 16 + i * 8192, R, C);
        int Rb = R;
        if constexpr (Epi::PERM == 1) Rb = (R & ~31) + perm32(R & 31);
        if constexpr (Epi::PERM == 2) Rb = 64 * (R >> 5) + 16 * ((R >> 2) & 3) + 4 * ((R >> 4) & 1) + (R & 3);
        voffB[i] = (unsigned)(Rb * K + C) * 2u; }
    const size_t kstep = (size_t)(BK * 2);
    const size_t hstepB = (size_t)(Epi::PERM == 2 ? 8 : HALF) * K * 2;
    const unsigned ldsw = (unsigned)wid * 1024u;
    const int aoff = lds_byte(wr * 64 + fr, fq * 8), boff = lds_byte(wc * 32 + fr, fq * 8);
#define PG8_SA(b, h) (((b) * 2 + (h)) * HTB)
#define PG8_SB(b, h) ((4 + (b) * 2 + (h)) * HTB)
#define PG8_STAGE_B(bufoff, gbase) do { _Pragma("unroll") for (int _i = 0; _i < 2; ++_i) \
        __builtin_amdgcn_global_load_lds((const unsigned*)((const char*)(gbase) + voffB[_i]), (LAS unsigned*)(lds + (bufoff) + ldsw + _i * 8192), 16, 0, 0); } while (0)
#define PG8_STAGE_A(bufoff, kbyte, OFF, h) do { _Pragma("unroll") for (int _i = 0; _i < 2; ++_i) \
        __builtin_amdgcn_global_load_lds((const unsigned*)(Ab + (kbyte) + OFF[(h) * 2 + _i]), (LAS unsigned*)(lds + (bufoff) + ldsw + _i * 8192), 16, 0, 0); } while (0)
#define PG8_LDA(dst, b, h) do { _Pragma("unroll") for (int m = 0; m < 4; ++m) _Pragma("unroll") for (int k = 0; k < 2; ++k) dst[m][k] = *(const LAS bf16x8*)(lds + PG8_SA(b, h) + aoff + m * 2048 + k * 1024); } while (0)
#define PG8_LDB(dst, b, h) do { _Pragma("unroll") for (int n = 0; n < 2; ++n) _Pragma("unroll") for (int k = 0; k < 2; ++k) dst[n][k] = *(const LAS bf16x8*)(lds + PG8_SB(b, h) + boff + n * 2048 + k * 1024); } while (0)
#define PG8_MMA(ai, bj, At, Bt) do { __builtin_amdgcn_s_setprio(1); if constexpr (FP8) { _Pragma("unroll") for (int m = 0; m < 4; ++m) _Pragma("unroll") for (int n = 0; n < 2; ++n) \
        acc[ai][bj][m][n] = __builtin_amdgcn_mfma_scale_f32_16x16x128_f8f6f4(__builtin_bit_cast(v8i32, (Frag2){Bt[n][0], Bt[n][1]}), __builtin_bit_cast(v8i32, (Frag2){At[m][0], At[m][1]}), acc[ai][bj][m][n], 0, 0, 0, s1v, 0, s2v); } else { \
        _Pragma("unroll") for (int m = 0; m < 4; ++m) _Pragma("unroll") for (int n = 0; n < 2; ++n) _Pragma("unroll") for (int k = 0; k < 2; ++k) \
        acc[ai][bj][m][n] = __builtin_amdgcn_mfma_f32_16x16x32_bf16(Bt[n][k], At[m][k], acc[ai][bj][m][n], 0, 0, 0); } __builtin_amdgcn_s_setprio(0); } while (0)
#define PG8_WAIT_V(n) asm volatile("s_waitcnt vmcnt(" #n ")" ::: "memory")
#define PG8_WAIT_L(n) asm volatile("s_waitcnt lgkmcnt(" #n ")" ::: "memory")
#define PG8_BAR __builtin_amdgcn_s_barrier()
#define PG8_SCHED __builtin_amdgcn_sched_barrier(0)
    typename Sched::Unit cur, nxt; int ui = 0;
    if (!S.next(0, cur)) return;
    f32x4 acc[2][2][4][2];
#pragma unroll
    for (int a = 0; a < 2; ++a)
#pragma unroll
        for (int b = 0; b < 2; ++b)
#pragma unroll
            for (int m = 0; m < 4; ++m)
#pragma unroll
                for (int n = 0; n < 2; ++n) acc[a][b][m][n] = (f32x4){0.f, 0.f, 0.f, 0.f};
    bf16x8 At[4][2], B0[2][2], B1[2][2];
    unsigned ao[4], no[4];
    const char* const Ab = S.abase();
    unsigned peek = 0u;
    if constexpr (Sched::HAS_READY) S.a_ready(cur, wid, 0u);
    S.aoffs(cur, tid, ao);
    if constexpr (Sched::PREFETCH) {
#pragma unroll
        for (int j = 0; j < 4; ++j) no[j] = ao[j];
    }
    const char* cB = S.bptr(cur);
    if constexpr (SP2) {
        PG8_STAGE_B(PG8_SB(0, 0), cB); PG8_STAGE_B(PG8_SB(0, 1), cB + hstepB); PG8_STAGE_A(PG8_SA(0, 0), 0, ao, 0); PG8_STAGE_A(PG8_SA(0, 1), 0, ao, 1);
        if (wr == 1) PG8_BAR;
        PG8_WAIT_V(2); PG8_BAR;
        PG8_STAGE_B(PG8_SB(1, 0), cB + kstep); PG8_STAGE_A(PG8_SA(1, 0), kstep, ao, 0); PG8_STAGE_B(PG8_SB(1, 1), cB + hstepB + kstep);
        PG8_WAIT_V(6); PG8_BAR;
    } else {
        PG8_STAGE_B(PG8_SB(0, 0), cB); PG8_STAGE_A(PG8_SA(0, 0), 0, ao, 0); PG8_STAGE_B(PG8_SB(0, 1), cB + hstepB); PG8_STAGE_A(PG8_SA(0, 1), 0, ao, 1);
        if (wr == 1) PG8_BAR;
        PG8_WAIT_V(4); PG8_BAR;
        PG8_STAGE_B(PG8_SB(1, 0), cB + kstep); PG8_STAGE_A(PG8_SA(1, 0), kstep, ao, 0); PG8_STAGE_B(PG8_SB(1, 1), cB + hstepB + kstep);
        PG8_WAIT_V(6); PG8_BAR;
    }
    for (;;) {
        const bool has_next = S.next(ui + 1, nxt);
        if constexpr (Sched::PREFETCH) { if (has_next) S.aoffs(nxt, tid, no); }
        if constexpr (Sched::HAS_READY) { if (has_next) peek = S.a_peek(nxt); }
        const char* nB = has_next ? S.bptr(nxt) : cB;
#pragma unroll 1
        for (int t = 0; t < nt; t += 2) {
            const bool last = (t == nt - 2);
            if constexpr (Sched::HAS_READY) { if (last && has_next) S.a_ready(nxt, wid, peek); }
            const size_t ka1 = (size_t)(t + 1) * kstep;
            const size_t k2 = last ? 0 : (size_t)(t + 2) * kstep, k3 = k2 + kstep;
            const char* b2 = last ? nB : cB + (size_t)(t + 2) * kstep; const char* b3 = b2 + kstep;
            if constexpr (SP2) {
            PG8_LDB(B0, 0, 0); PG8_LDB(B1, 0, 1); PG8_SCHED; PG8_LDA(At, 0, 0); PG8_STAGE_A(PG8_SA(1, 1), ka1, ao, 1);
            if (last && has_next) {
                if constexpr (Sched::PREFETCH) {
#pragma unroll
                    for (int j = 0; j < 4; ++j) ao[j] = no[j];
                } else S.aoffs(nxt, tid, ao);
            }
            PG8_WAIT_V(8); PG8_WAIT_L(0); PG8_BAR; PG8_MMA(0, 0, At, B0); PG8_MMA(0, 1, At, B1); PG8_BAR; PG8_SCHED;
            PG8_LDA(At, 0, 1); PG8_STAGE_B(PG8_SB(0, 0), b2); PG8_STAGE_B(PG8_SB(0, 1), b2 + hstepB); PG8_STAGE_A(PG8_SA(0, 0), k2, ao, 0);
            PG8_WAIT_V(8); PG8_WAIT_L(0); PG8_BAR; PG8_MMA(1, 0, At, B0); PG8_MMA(1, 1, At, B1); PG8_BAR; PG8_SCHED;
            PG8_LDB(B0, 1, 0); PG8_LDB(B1, 1, 1); PG8_SCHED; PG8_LDA(At, 1, 0); PG8_STAGE_A(PG8_SA(0, 1), k2, ao, 1);
            PG8_WAIT_V(8); PG8_WAIT_L(0); PG8_BAR; PG8_MMA(0, 0, At, B0); PG8_MMA(0, 1, At, B1); PG8_BAR; PG8_SCHED;
            PG8_LDA(At, 1, 1); PG8_STAGE_B(PG8_SB(1, 0), b3); PG8_STAGE_B(PG8_SB(1, 1), b3 + hstepB); PG8_STAGE_A(PG8_SA(1, 0), k3, ao, 0);
            PG8_WAIT_V(8); PG8_WAIT_L(0); PG8_BAR; PG8_MMA(1, 0, At, B0); PG8_MMA(1, 1, At, B1); PG8_BAR; PG8_SCHED;
            } else {
            PG8_LDB(B0, 0, 0); PG8_SCHED; PG8_LDA(At, 0, 0); PG8_STAGE_A(PG8_SA(1, 1), ka1, ao, 1);
            if (last && has_next) {
                if constexpr (Sched::PREFETCH) {
#pragma unroll
                    for (int j = 0; j < 4; ++j) ao[j] = no[j];
                } else S.aoffs(nxt, tid, ao);
            }
            PG8_WAIT_L(8); PG8_BAR; PG8_WAIT_L(0); PG8_MMA(0, 0, At, B0); PG8_BAR; PG8_SCHED;
            PG8_LDB(B1, 0, 1); PG8_STAGE_B(PG8_SB(0, 0), b2);
            PG8_BAR; PG8_WAIT_L(0); PG8_MMA(0, 1, At, B1); PG8_BAR;
            PG8_LDA(At, 0, 1); PG8_STAGE_A(PG8_SA(0, 0), k2, ao, 0);
            PG8_BAR; PG8_WAIT_L(0); PG8_MMA(1, 0, At, B0); PG8_BAR; PG8_SCHED;
            PG8_STAGE_B(PG8_SB(0, 1), b2 + hstepB);
            PG8_WAIT_V(6); PG8_BAR; PG8_MMA(1, 1, At, B1); PG8_BAR;
            PG8_LDB(B0, 1, 0); PG8_SCHED; PG8_LDA(At, 1, 0); PG8_STAGE_A(PG8_SA(0, 1), k2, ao, 1);
            PG8_WAIT_L(8); PG8_BAR; PG8_WAIT_L(0); PG8_MMA(0, 0, At, B0); PG8_BAR; PG8_SCHED;
            PG8_LDB(B1, 1, 1); PG8_STAGE_B(PG8_SB(1, 0), b3);
            PG8_BAR; PG8_WAIT_L(0); PG8_MMA(0, 1, At, B1); PG8_BAR;
            PG8_LDA(At, 1, 1); PG8_STAGE_A(PG8_SA(1, 0), k3, ao, 0);
            PG8_BAR; PG8_WAIT_L(0); PG8_MMA(1, 0, At, B0); PG8_BAR; PG8_SCHED;
            PG8_STAGE_B(PG8_SB(1, 1), b3 + hstepB);
            PG8_WAIT_V(6); PG8_BAR; PG8_MMA(1, 1, At, B1); PG8_BAR;
                    }
        }
        if constexpr (ALIGN_EPI) { if (wr == 0) PG8_BAR; }
        E(acc, cur, wr, wc, fr, fq);
        if (!has_next) break;
#pragma unroll
        for (int a = 0; a < 2; ++a)
#pragma unroll
            for (int b = 0; b < 2; ++b)
#pragma unroll
                for (int m = 0; m < 4; ++m)
#pragma unroll
                    for (int n = 0; n < 2; ++n) acc[a][b][m][n] = (f32x4){0.f, 0.f, 0.f, 0.f};
        cur = nxt; cB = nB; ++ui;
        if constexpr (ALIGN_EPI) { if (wr == 1) PG8_BAR; }
    }
    PG8_WAIT_V(0);
    if constexpr (Epi::HAS_FINISH) E.finish(fr, fq);
    if constexpr (!ALIGN_EPI) { if (wr == 0) PG8_BAR; }
    PG8_BAR;
#undef PG8_SA
#undef PG8_SB
#undef PG8_STAGE_A
#undef PG8_STAGE_B
#undef PG8_LDA
#undef PG8_LDB
#undef PG8_MMA
#undef PG8_WAIT_V
#undef PG8_WAIT_L
#undef PG8_BAR
#undef PG8_SCHED
}

struct DUnit { int pm, pn, orow0, ocol0; };
struct DenseSched {
    const char* A; unsigned ldaB; const char* Bt; int K; int nM, nN, nwg, G, c;
    typedef DUnit Unit;
    __device__ __forceinline__ void init(const void* A_, int lda_elems, const void* Bt_, int M, int N, int K_, int G_, int c_) {
        A = (const char*)A_; ldaB = (unsigned)lda_elems * 2u; Bt = (const char*)Bt_; K = K_; nM = M / 256; nN = N / 256; nwg = nM * nN; G = G_; c = c_; }
    __device__ __forceinline__ bool next(int i, Unit& u) const {
        const int L = i * G + c; if (L >= nwg) return false;
        int wgid = L; { const int q = nwg / 8, r = nwg % 8, xcd = wgid % 8, off = wgid / 8; wgid = (xcd < r ? xcd * (q + 1) : r * (q + 1) + (xcd - r) * q) + off; }
        const int nig = 8 * nN, gid = wgid / nig, fm = gid * 8, gsz = (nM - fm) < 8 ? (nM - fm) : 8;
        u.pm = fm + ((wgid % nig) % gsz); u.pn = (wgid % nig) / gsz; u.orow0 = u.pm * 256; u.ocol0 = u.pn * 256; return true;
    }
    __device__ __forceinline__ const char* abase() const { return A; }
    static constexpr bool PREFETCH = false, HAS_READY = false;
    __device__ __forceinline__ void aoffs(const Unit& u, int tid, unsigned (&o)[4]) const {
#pragma unroll
        for (int i = 0; i < 2; ++i) { int R, C; stage_rc(tid * 16 + i * 8192, R, C);
#pragma unroll
            for (int h = 0; h < 2; ++h) o[h * 2 + i] = (unsigned)(u.pm * 256 + h * 128 + R) * ldaB + (unsigned)(C * 2); }
    }
    __device__ __forceinline__ const char* bptr(const Unit& u) const { return Bt + (size_t)u.pn * 256 * K * 2; }
};

struct MUnit { int e, mt, pn, orow0, ocol0; };
struct MoeGUSched {
    const char* Hb; const char* W; const int* list; const LAS int* pref; const LAS int* cnt; int total, G, c;
    unsigned rowB;
    typedef MUnit Unit;
    __device__ __forceinline__ bool next(int i, Unit& u) const {
        const int L = i * G + c; if (L >= total) return false;
        const int mtg = L >> 2; u.pn = L & 3;
        int e = pref[400 + mtg];
        e = __builtin_amdgcn_readfirstlane(e);
        u.e = e; u.mt = mtg - pref[e]; u.orow0 = mtg * 256; u.ocol0 = u.pn * 128; return true;
    }
    __device__ __forceinline__ const char* abase() const { return Hb; }
    static constexpr bool PREFETCH = true, HAS_READY = false;
    __device__ __forceinline__ void aoffs(const Unit& u, int tid, unsigned (&o)[4]) const {
        const int n = cnt[u.e];
#pragma unroll
        for (int i = 0; i < 2; ++i) { int R, C; stage_rc(tid * 16 + i * 8192, R, C);
#pragma unroll
            for (int h = 0; h < 2; ++h) { const int pos = u.mt * 256 + h * 128 + R;
                int tok = pos; if (u.e < 64) tok = (pos < n) ? list[u.e * 8192 + pos] : 0;
                o[h * 2 + i] = (unsigned)tok * rowB + (unsigned)(C * 2); } }
    }
    __device__ __forceinline__ const char* bptr(const Unit& u) const { return W + ((size_t)u.e * 1024 + (size_t)u.pn * 256) * rowB; }
};
struct MoeDownSched {
    const char* Act; const char* W; const LAS int* pref; int total, G, c;
    int n6, lead;
    unsigned* ready;
    unsigned* tmo;
    unsigned rowB;
    typedef MUnit Unit;
    __device__ __forceinline__ unsigned a_peek(const Unit& u) const { return __hip_atomic_load(ready + 64 * (u.orow0 >> 8), __ATOMIC_RELAXED, __HIP_MEMORY_SCOPE_AGENT); }
    __device__ __forceinline__ void a_ready(const Unit& u, int wid, unsigned peeked) const {
        if (wid == 0) {
            unsigned* w = ready + 64 * (u.orow0 >> 8); unsigned sp = 0;
            if ((unsigned)__builtin_amdgcn_readfirstlane(peeked) < 32u)
            while ((unsigned)__builtin_amdgcn_readfirstlane(__hip_atomic_load(w, __ATOMIC_RELAXED, __HIP_MEMORY_SCOPE_AGENT)) < 32u) {
                __builtin_amdgcn_s_sleep(2);
                if ((++sp & 255u) == 0u) { if (__hip_atomic_load(tmo, __ATOMIC_RELAXED, __HIP_MEMORY_SCOPE_AGENT) != 0u) break;
                    if (sp > (1u << 22)) { __hip_atomic_store(tmo, 1u, __ATOMIC_RELAXED, __HIP_MEMORY_SCOPE_AGENT); break; } }
            }
            __builtin_amdgcn_fence(__ATOMIC_ACQUIRE, "agent");
            asm volatile("s_waitcnt vmcnt(0)" ::: "memory");
        }
        __builtin_amdgcn_s_barrier();
    }
    __device__ __forceinline__ bool next(int i, Unit& u) const {
        int L;
        if (lead) L = (i < DOWN_LEAD) ? i * (G - n6) + c : DOWN_LEAD * (G - n6) + (i - DOWN_LEAD) * G + c;
        else L = DOWN_LEAD * (G - n6) + i * G + c;
        if (L >= total) return false;
        const int mtg = L >> 3; u.pn = L & 7;
        int e = pref[400 + mtg];
        e = __builtin_amdgcn_readfirstlane(e);
        u.e = e; u.mt = mtg - pref[e]; u.orow0 = mtg * 256; u.ocol0 = u.pn * 256; return true;
    }
    __device__ __forceinline__ const char* abase() const { return Act; }
    static constexpr bool PREFETCH = false, HAS_READY = true;
    __device__ __forceinline__ void aoffs(const Unit& u, int tid, unsigned (&o)[4]) const {
#pragma unroll
        for (int i = 0; i < 2; ++i) { int R, C; stage_rc(tid * 16 + i * 8192, R, C);
#pragma unroll
            for (int h = 0; h < 2; ++h) o[h * 2 + i] = (unsigned)(u.orow0 + h * 128 + R) * rowB + (unsigned)(C * 2); }
    }
    __device__ __forceinline__ const char* bptr(const Unit& u) const { return W + ((size_t)u.e * 2048 + (size_t)u.pn * 256) * rowB; }
};

template <bool NT = false> struct EpiBf16T {
    static constexpr int PERM = 1; static constexpr bool HAS_FINISH = false;
    bf16* O; int ldc;
    template <class U> __device__ __forceinline__ void operator()(const f32x4 (&acc)[2][2][4][2], const U& u, int wr, int wc, int fr, int fq) const {
        const int row0 = u.orow0 + wr * 64 + fr, col0 = u.ocol0 + wc * 32 + 8 * fq;
#pragma unroll
        for (int ai = 0; ai < 2; ++ai)
#pragma unroll
            for (int m = 0; m < 4; ++m) { bf16* rowp = O + (size_t)(row0 + ai * HALF + m * 16) * ldc + col0;
#pragma unroll
                for (int bj = 0; bj < 2; ++bj) { const f32x4 v0 = acc[ai][bj][m][0], v1 = acc[ai][bj][m][1];
                    u32x4 w; w.x = cvt_pk_bf16(v0[0], v0[1]); w.y = cvt_pk_bf16(v0[2], v0[3]); w.z = cvt_pk_bf16(v1[0], v1[1]); w.w = cvt_pk_bf16(v1[2], v1[3]);
                    if constexpr (NT) __builtin_nontemporal_store(w, (u32x4*)(rowp + bj * HALF)); else *(u32x4*)(rowp + bj * HALF) = w; } }
    }
};
typedef EpiBf16T<false> EpiBf16;
struct EpiFp8 {
    static constexpr int PERM = 2; static constexpr bool HAS_FINISH = false;
    unsigned char* O; int ldc; float scale;
    template <class U> __device__ __forceinline__ void operator()(const f32x4 (&acc)[2][2][4][2], const U& u, int wr, int wc, int fr, int fq) const {
        const int row0 = u.orow0 + wr * 64 + fr, col0 = u.ocol0 + wc * 64 + 16 * fq;
#pragma unroll
        for (int ai = 0; ai < 2; ++ai)
#pragma unroll
            for (int m = 0; m < 4; ++m) { u32x4 w;
#pragma unroll
                for (int bj = 0; bj < 2; ++bj) { const f32x4 v0 = acc[ai][bj][m][0] * scale, v1 = acc[ai][bj][m][1] * scale;
                    int a = __builtin_amdgcn_cvt_pk_fp8_f32(clamp8(v0[0]), clamp8(v0[1]), 0, false); a = __builtin_amdgcn_cvt_pk_fp8_f32(clamp8(v0[2]), clamp8(v0[3]), a, true);
                    int b = __builtin_amdgcn_cvt_pk_fp8_f32(clamp8(v1[0]), clamp8(v1[1]), 0, false); b = __builtin_amdgcn_cvt_pk_fp8_f32(clamp8(v1[2]), clamp8(v1[3]), b, true);
                    if (bj == 0) { w.x = (unsigned)a; w.y = (unsigned)b; } else { w.z = (unsigned)a; w.w = (unsigned)b; } }
                *(u32x4*)(O + (size_t)(row0 + ai * HALF + m * 16) * ldc + col0) = w; }
    }
};
__device__ __forceinline__ float silu_mul(float g, float u) { return g * u * __builtin_amdgcn_rcpf(1.f + __builtin_amdgcn_exp2f(-1.4426950408889634f * g)); }
template <bool F8> struct EpiGateUpT {
    static constexpr int PERM = 1;
    bf16* O; unsigned* ready; mutable int pend = -1;
    static constexpr bool HAS_FINISH = true;
    __device__ __forceinline__ void finish(int fr, int fq) const {
        if (pend >= 0 && fr == 0 && fq == 0) __hip_atomic_fetch_add(ready + 64 * pend, 1u, __ATOMIC_RELAXED, __HIP_MEMORY_SCOPE_AGENT);
        pend = -1; }
    template <class U> __device__ __forceinline__ void operator()(const f32x4 (&acc)[2][2][4][2], const U& u, int wr, int wc, int fr, int fq) const {
        if (pend >= 0 && fr == 0 && fq == 0) __hip_atomic_fetch_add(ready + 64 * pend, 1u, __ATOMIC_RELAXED, __HIP_MEMORY_SCOPE_AGENT);
        pend = u.orow0 >> 8;
        const int row0 = u.orow0 + wr * 64 + fr, col0 = u.ocol0 + wc * 32 + 8 * fq;
        const __amdgpu_buffer_rsrc_t rs = __builtin_amdgcn_make_buffer_rsrc(O, 0, (unsigned)((size_t)SLOT_MAX * FFE * 2), 0x00020000);
#pragma unroll
        for (int ai = 0; ai < 2; ++ai)
#pragma unroll
            for (int m = 0; m < 4; ++m) { const unsigned eo = (unsigned)((row0 + ai * HALF + m * 16) * FFE + col0);
                const f32x4 g0 = acc[ai][0][m][0], g1 = acc[ai][0][m][1], u0 = acc[ai][1][m][0], u1 = acc[ai][1][m][1];
                if constexpr (F8) {
                    int a = __builtin_amdgcn_cvt_pk_fp8_f32(clamp8(silu_mul(g0[0], u0[0]) * ACT8_SCALE), clamp8(silu_mul(g0[1], u0[1]) * ACT8_SCALE), 0, false);
                    a = __builtin_amdgcn_cvt_pk_fp8_f32(clamp8(silu_mul(g0[2], u0[2]) * ACT8_SCALE), clamp8(silu_mul(g0[3], u0[3]) * ACT8_SCALE), a, true);
                    int b = __builtin_amdgcn_cvt_pk_fp8_f32(clamp8(silu_mul(g1[0], u1[0]) * ACT8_SCALE), clamp8(silu_mul(g1[1], u1[1]) * ACT8_SCALE), 0, false);
                    b = __builtin_amdgcn_cvt_pk_fp8_f32(clamp8(silu_mul(g1[2], u1[2]) * ACT8_SCALE), clamp8(silu_mul(g1[3], u1[3]) * ACT8_SCALE), b, true);
                    __builtin_amdgcn_raw_buffer_store_b64((u32x2){(unsigned)a, (unsigned)b}, rs, eo, 0, 16);
                } else {
                u32x4 w; w.x = cvt_pk_bf16(silu_mul(g0[0], u0[0]), silu_mul(g0[1], u0[1])); w.y = cvt_pk_bf16(silu_mul(g0[2], u0[2]), silu_mul(g0[3], u0[3]));
                w.z = cvt_pk_bf16(silu_mul(g1[0], u1[0]), silu_mul(g1[1], u1[1])); w.w = cvt_pk_bf16(silu_mul(g1[2], u1[2]), silu_mul(g1[3], u1[3]));
                __builtin_amdgcn_raw_buffer_store_b128(w, rs, eo * 2u, 0, 16); } }
    }
};
typedef EpiGateUpT<false> EpiGateUp;
struct EpiResid {
    static constexpr int PERM = 0; static constexpr bool HAS_FINISH = false;
    const float* X; const float* gate  ; float* Y;
    template <class U> __device__ __forceinline__ void operator()(const f32x4 (&acc)[2][2][4][2], const U& u, int wr, int wc, int fr, int fq) const {
        const int row0 = u.orow0 + wr * 64 + fr, col0 = u.ocol0 + wc * 32 + 4 * fq; const int b = u.orow0 >> 12;
        f32x4 gv[2][2];
#pragma unroll
        for (int bj = 0; bj < 2; ++bj)
#pragma unroll
            for (int n = 0; n < 2; ++n) gv[bj][n] = *(const f32x4*)(gate + (size_t)b * ADA_W + col0 + bj * HALF + 16 * n) + 1.0f;
#pragma unroll
        for (int ai = 0; ai < 2; ++ai)
#pragma unroll
            for (int m = 0; m < 4; ++m) { const size_t ro = (size_t)(row0 + ai * HALF + m * 16) * DM + col0;
#pragma unroll
                for (int bj = 0; bj < 2; ++bj)
#pragma unroll
                    for (int n = 0; n < 2; ++n) { const f32x4 xv = *(const f32x4*)(X + ro + bj * HALF + 16 * n);
                        *(f32x4*)(Y + ro + bj * HALF + 16 * n) = xv * DN_ALPHA + gv[bj][n] * acc[ai][bj][m][n]; } }
    }
};
}

namespace att {
constexpr int NW = 8;
enum { MODE_MLA = 0, MODE_NA = 1, MODE_DIFF = 2 };
constexpr float LOG2E = 1.4426950408889634f;
constexpr float THR = 8.f;
constexpr int SHM_V = 16384, SHM_K = 24576;
constexpr int LDS_VBUF = 0, LDS_KBUF = 3 * SHM_V, LDS_WS = LDS_KBUF + 3 * SHM_K, LDS_RPB = LDS_WS + NW * 64 * 4, LDS_END = LDS_RPB + 2048;
static_assert(LDS_END <= MISC_OFF, "attention LDS");
#define KSWZ128(row, colB) ((row) * 256 + ((colB) ^ (((row) & 15) << 4)))
#define KSWZ64(row, colB)  ((row) * 128 + ((colB) ^ ((((row) >> 1) & 7) << 4)))
#define SBAR() __builtin_amdgcn_sched_barrier(0)
__device__ __forceinline__ int crow(int r, int hi) { return (r & 3) + 8 * (r >> 2) + 4 * hi; }

struct AttnP {
    const bf16* U; const bf16* QM; const bf16* KVM; bf16* MIX; float* O1; float* O2;
    const f32x2* ropeM; const float* rpb  ;
};

template <int MODE> struct Cfg;
template <> struct Cfg<MODE_MLA>  { static constexpr float SCALE = 0.07216878364870322f; static constexpr int NQ = 12; };
template <> struct Cfg<MODE_NA>   { static constexpr float SCALE = 0.08838834764831845f; static constexpr int NQ = 8; };
template <> struct Cfg<MODE_DIFF> { static constexpr float SCALE = 0.125f;               static constexpr int NQ = 4; };

template <int MODE>
__device__ __forceinline__ void partialSM(f32x16& p0, f32x16& p1, float& m_reg, float& mn, float& alpha) {
    constexpr float SCALE = Cfg<MODE>::SCALE, C = SCALE * LOG2E;
    float pmax = p0[0];
#pragma unroll
    for (int r = 1; r < 16; ++r) pmax = fmaxf(pmax, p0[r]);
#pragma unroll
    for (int r = 0; r < 16; ++r) pmax = fmaxf(pmax, p1[r]);
    { auto rr = __builtin_amdgcn_permlane32_swap(__float_as_uint(pmax), __float_as_uint(pmax), false, false);
      pmax = fmaxf(__uint_as_float(rr[0]), __uint_as_float(rr[1])); }
    if (__builtin_expect(__all(pmax - m_reg <= THR / SCALE), 1)) { mn = m_reg; alpha = 1.f; }
    else { mn = fmaxf(m_reg, pmax); alpha = __builtin_amdgcn_exp2f((m_reg - mn) * C); m_reg = mn; }
    const float mnC = -mn * C;
#pragma unroll
    for (int r = 0; r < 16; ++r) p0[r] = fmaf(p0[r], C, mnC);
#pragma unroll
    for (int r = 0; r < 16; ++r) p1[r] = fmaf(p1[r], C, mnC);
#pragma unroll
    for (int r = 0; r < 16; ++r) p0[r] = __builtin_amdgcn_exp2f(p0[r]);
}
__device__ __forceinline__ void finishSM(f32x16& p0, f32x16& p1, float alpha, float& l_reg, bf16x8& pa0, bf16x8& pa1, bf16x8& pa2, bf16x8& pa3) {
#pragma unroll
    for (int r = 0; r < 16; ++r) p1[r] = __builtin_amdgcn_exp2f(p1[r]);
    float ps = 0;
#pragma unroll
    for (int r = 0; r < 16; ++r) ps += p0[r];
#pragma unroll
    for (int r = 0; r < 16; ++r) ps += p1[r];
    { auto rr = __builtin_amdgcn_permlane32_swap(__float_as_uint(ps), __float_as_uint(ps), false, false);
      ps = __uint_as_float(rr[0]) + __uint_as_float(rr[1]); }
    l_reg = l_reg * alpha + ps;
#define PK4(P, BASE, OUT) do { unsigned a0 = cvt_pk_bf16(P[BASE + 0], P[BASE + 1]), a1 = cvt_pk_bf16(P[BASE + 2], P[BASE + 3]);   \
    unsigned b0 = cvt_pk_bf16(P[BASE + 4], P[BASE + 5]), b1 = cvt_pk_bf16(P[BASE + 6], P[BASE + 7]);                              \
    auto r0 = __builtin_amdgcn_permlane32_swap(a0, b0, false, false); auto r1 = __builtin_amdgcn_permlane32_swap(a1, b1, false, false); \
    u32x4 w = {r0[0], r1[0], r0[1], r1[1]}; OUT = __builtin_bit_cast(bf16x8, w); } while (0)
    PK4(p0, 0, pa0); PK4(p0, 8, pa1); PK4(p1, 0, pa2); PK4(p1, 8, pa3);
#undef PK4
}
#ifndef QK_PD
#define QK_PD 3
#endif
#ifndef ATT2
#define ATT2 4
#endif
#ifndef ATT_GLDS
#define ATT_GLDS 1
#endif
template <int MODE, int D0>
__device__ __forceinline__ void kfrag(const LAS char* Kb, int r32, int hi, bf16x8& b0, bf16x8& b1) {
    if constexpr (MODE == MODE_DIFF) { constexpr int cbase = D0 * 32; const int cb = cbase + hi * 16;
        b0 = *(const LAS bf16x8*)(Kb + KSWZ64(r32, cb)); b1 = *(const LAS bf16x8*)(Kb + KSWZ64(32 + r32, cb)); }
    else if constexpr (D0 < 8) { const int cb = D0 * 32 + hi * 16;
        b0 = *(const LAS bf16x8*)(Kb + KSWZ128(r32, cb)); b1 = *(const LAS bf16x8*)(Kb + KSWZ128(32 + r32, cb)); }
    else { const int cb = (D0 - 8) * 32 + hi * 16; const LAS char* Kr = Kb + 16384;
        b0 = *(const LAS bf16x8*)(Kr + KSWZ64(r32, cb)); b1 = *(const LAS bf16x8*)(Kr + KSWZ64(32 + r32, cb)); }
}
template <int MODE, int D0, int NS>
__device__ __forceinline__ void qk_step(f32x16& p0, f32x16& p1, const LAS char* Kb, const bf16x8* qr, int r32, int hi, bf16x8 (&f0)[NS], bf16x8 (&f1)[NS]) {
    if constexpr (D0 < NS) {
        if constexpr (D0 + QK_PD < NS) kfrag<MODE, D0 + QK_PD>(Kb, r32, hi, f0[D0 + QK_PD], f1[D0 + QK_PD]);
        p0 = __builtin_amdgcn_mfma_f32_32x32x16_bf16(f0[D0], qr[D0], p0, 0, 0, 0);
        p1 = __builtin_amdgcn_mfma_f32_32x32x16_bf16(f1[D0], qr[D0], p1, 0, 0, 0);
        SBAR();
        qk_step<MODE, D0 + 1, NS>(p0, p1, Kb, qr, r32, hi, f0, f1);
    }
}
template <int MODE>
__device__ __forceinline__ void qkt(f32x16& p0, f32x16& p1, const LAS char* Kb, const bf16x8* qr, int r32, int hi) {
    constexpr int NS = Cfg<MODE>::NQ;
    p0 = f32x16{}; p1 = f32x16{};
    bf16x8 f0[NS], f1[NS];
    kfrag<MODE, 0>(Kb, r32, hi, f0[0], f1[0]);
    if constexpr (QK_PD > 1 && NS > 1) kfrag<MODE, 1>(Kb, r32, hi, f0[1], f1[1]);
    if constexpr (QK_PD > 2 && NS > 2) kfrag<MODE, 2>(Kb, r32, hi, f0[2], f1[2]);
    if constexpr (QK_PD > 3 && NS > 3) kfrag<MODE, 3>(Kb, r32, hi, f0[3], f1[3]);
    SBAR();
    qk_step<MODE, 0, NS>(p0, p1, Kb, qr, r32, hi, f0, f1);
}
__device__ __forceinline__ int v_st(int k, int c) { const int kk = (k & ~0xC) | ((k & 4) << 1) | ((k & 8) >> 1); return ((kk >> 3) * 4 + (c >> 5)) * 512 + ((kk & 7) * 32 + (c & 31)) * 2; }
__device__ __forceinline__ int v_rd_base(int lane) { return ((lane & 3) << 3) | (((lane >> 2) & 3) << 6) | (((lane >> 4) & 1) << 5) | (((lane >> 5) & 1) << 8); }
constexpr int v_rd_off(int d0, int ks, int half) { return d0 * 512 + ks * 4096 + half * 2048; }
template <int OFF> __device__ __forceinline__ s16x4 tr_read(int vb) {
    s16x4 r; asm volatile("ds_read_b64_tr_b16 %0, %1 offset:%2" : "=&v"(r) : "v"(vb), "i"(OFF) : "memory"); return r;
}
template <int D0> __device__ __forceinline__ void pv_one(f32x16& od, int vb, bf16x8 pa0, bf16x8 pa1, bf16x8 pa2, bf16x8 pa3) {
    const s16x4 l0 = tr_read<v_rd_off(D0, 0, 0)>(vb), h0 = tr_read<v_rd_off(D0, 0, 1)>(vb), l1 = tr_read<v_rd_off(D0, 1, 0)>(vb), h1 = tr_read<v_rd_off(D0, 1, 1)>(vb);
    const s16x4 l2 = tr_read<v_rd_off(D0, 2, 0)>(vb), h2 = tr_read<v_rd_off(D0, 2, 1)>(vb), l3 = tr_read<v_rd_off(D0, 3, 0)>(vb), h3 = tr_read<v_rd_off(D0, 3, 1)>(vb);
    asm volatile("s_waitcnt lgkmcnt(0)" ::: "memory"); SBAR();
#define PK(L, H) (bf16x8){L[0], L[1], L[2], L[3], H[0], H[1], H[2], H[3]}
    od = __builtin_amdgcn_mfma_f32_32x32x16_bf16(pa0, PK(l0, h0), od, 0, 0, 0);
    od = __builtin_amdgcn_mfma_f32_32x32x16_bf16(pa1, PK(l1, h1), od, 0, 0, 0);
    od = __builtin_amdgcn_mfma_f32_32x32x16_bf16(pa2, PK(l2, h2), od, 0, 0, 0);
    od = __builtin_amdgcn_mfma_f32_32x32x16_bf16(pa3, PK(l3, h3), od, 0, 0, 0);
#undef PK
}
__device__ __forceinline__ void pv_d0(f32x16* o, int vb, bf16x8 pa0, bf16x8 pa1, bf16x8 pa2, bf16x8 pa3) {
    pv_one<0>(o[0], vb, pa0, pa1, pa2, pa3); pv_one<1>(o[1], vb, pa0, pa1, pa2, pa3); pv_one<2>(o[2], vb, pa0, pa1, pa2, pa3); pv_one<3>(o[3], vb, pa0, pa1, pa2, pa3);
}
__device__ __forceinline__ void na_bias_mask(f32x16& p0, f32x16& p1, const LAS float* rpbL, int kr, int rq, int qc, int hi) {
    constexpr float INVS = 11.313708498984761f;
    const int r0 = min(max(rq - 4, 0), 56);
    const bool tv = (kr >= r0) && (kr < r0 + 8);
    const int dr = min(max(kr - rq + 7, 0), 14);
    const int c0 = min(max(qc - 8, 0), 48);
    const LAS float* row = rpbL + dr * 31;
    const float NINF = -__builtin_huge_valf();
#pragma unroll
    for (int r = 0; r < 16; ++r) { const int kc = crow(r, hi);
        const bool ok = tv && kc >= c0 && kc < c0 + 16; const int ix = min(max(kc - qc + 15, 0), 30); const float bv = row[ix]; p0[r] = ok ? fmaf(bv, INVS, p0[r]) : NINF; }
    SBAR();
#pragma unroll
    for (int r = 0; r < 16; ++r) { const int kc2 = crow(r, hi) + 32;
        const bool ok = tv && kc2 >= c0 && kc2 < c0 + 16; const int ix = min(max(kc2 - qc + 15, 0), 30); const float bv = row[ix]; p1[r] = ok ? fmaf(bv, INVS, p1[r]) : NINF; }
}

template <int MODE, int PASS = 0>
__device__ __forceinline__ void attn_unit(const AttnP& P, const int uid, LAS char* lds) {
    constexpr int NQ = Cfg<MODE>::NQ;
    constexpr int NH = (MODE == MODE_MLA) ? 8 : 4;
    int tid = tid_x(); asm volatile("" : "+v"(tid));
    const int wid = tid >> 6, lane = tid & 63, r32 = lane & 31, hi = lane >> 5;
    const int qb = uid & 15, h = (uid >> 4) % NH, b = (uid >> 4) / NH;
    const int tok0 = b * SEQ;
    const int qrow = tok0 + qb * 256 + wid * 32 + r32;
    LAS char* V_lds = lds + LDS_VBUF; LAS char* K_lds = lds + LDS_KBUF;
    LAS float* ws = (LAS float*)(lds + LDS_WS) + wid * 64; LAS float* li_l = ws; LAS float* al_l = ws + 32;
    LAS float* rpbL = (LAS float*)(lds + LDS_RPB);
    const int sr = tid >> 4, sc = (tid & 15) * 8, vst0 = v_st(sr, sc), vst1 = v_st(32 + sr, sc);
    const int sr64 = tid >> 3, sc64 = (tid & 7) * 8;
    const int vb0 = (int)(unsigned)(uintptr_t)V_lds + v_rd_base(lane);
    int NT = 64, kbase = tok0;
    int rq = 0, qc = 0, kr_lo = 0;
    if constexpr (MODE == MODE_NA) { const int rq0 = qb * 4; kr_lo = min(min(max(rq0 - 4, 0), 56), 52); NT = 12; kbase = tok0 + kr_lo * 64; rq = rq0 + (wid >> 1); qc = (wid & 1) * 32 + r32;
        for (int i = tid; i < 15 * 31; i += 512) rpbL[i] = P.rpb[h * 465 + i];
        __syncthreads(); }
    const bf16* Kg; const bf16* Vg; const bf16* Kg2 = nullptr; int ldk, ldv;
    if constexpr (MODE == MODE_MLA) { Kg = P.KVM + h * 256; Vg = P.KVM + h * 256 + 128; Kg2 = P.U + U_KR; ldk = KVW; ldv = KVW; }
    else if constexpr (MODE == MODE_NA) { Kg = P.U + U_NA + 512 + h * 128; Vg = P.U + U_NA + 1024 + h * 128; ldk = UW; ldv = UW; }
    else { Kg = P.U + U_DF + 512 + h * 128; Vg = P.U + U_DF + 1024 + h * 128; ldk = UW; ldv = UW; }

    constexpr int pass = PASS;
    constexpr bool HALF_OFFSET = false;
    {
        float m_reg = -1e30f, l_reg = 0; f32x16 o[4] = {}; bf16x8 qr[NQ];
        if constexpr (MODE == MODE_MLA) {
            const bf16* Qw = P.QM + (size_t)qrow * QMW + h * 192 + hi * 8;
#pragma unroll
            for (int d0 = 0; d0 < 12; ++d0) qr[d0] = *(const bf16x8*)(Qw + d0 * 16);
            const f32x2* rt = P.ropeM + (size_t)(qrow & (SEQ - 1)) * 32;
#pragma unroll
            for (int g = 0; g < 2; ++g) {
                bf16x8 x1 = qr[8 + g], x2 = qr[10 + g];
#pragma unroll
                for (int e = 0; e < 8; ++e) { const f32x2 cs = rt[g * 16 + hi * 8 + e];
                    const float a = bf2f((unsigned short)x1[e]), c = bf2f((unsigned short)x2[e]);
                    const float ra = a * cs.x - c * cs.y, rc = c * cs.x + a * cs.y;
                    x1[e] = (short)(cvt_pk_bf16(ra, 0.f) & 0xffffu); x2[e] = (short)(cvt_pk_bf16(rc, 0.f) & 0xffffu); }
                qr[8 + g] = x1; qr[10 + g] = x2;
            }
        } else if constexpr (MODE == MODE_NA) {
            const bf16* Qw = P.U + (size_t)qrow * UW + U_NA + h * 128 + hi * 8;
#pragma unroll
            for (int d0 = 0; d0 < 8; ++d0) qr[d0] = *(const bf16x8*)(Qw + d0 * 16);
        } else {
            const bf16* Qw = P.U + (size_t)qrow * UW + U_DF + h * 128 + pass * 64 + hi * 8;
#pragma unroll
            for (int d0 = 0; d0 < 4; ++d0) qr[d0] = *(const bf16x8*)(Qw + d0 * 16);
        }
        const bf16* Kp = (MODE == MODE_DIFF) ? Kg + pass * 64 : Kg;
        bf16x8 s_v0, s_v1, s_k0, s_k1, s_k2;
        const unsigned voffA = (unsigned)(sr * ldv + sc) * 2u, voffB = (unsigned)((32 + sr) * ldv + sc) * 2u;
        const unsigned koffA = (unsigned)(sr * ldk + sc) * 2u, koffB = (unsigned)((32 + sr) * ldk + sc) * 2u;
        const unsigned koff64 = (unsigned)(sr64 * ldk + sc64) * 2u, k2off = (unsigned)(sr64 * UW + sc64) * 2u;
#define SLOAD(t) do { const size_t kt = (size_t)(kbase + (t) * 64); const bf16* Vt = Vg + kt * ldv; const bf16* Kt = Kp + kt * ldk; \
        s_v0 = ldg_b128(Vt, voffA); s_v1 = ldg_b128(Vt, voffB); \
        if constexpr (MODE == MODE_DIFF) { s_k0 = ldg_b128(Kt, koff64); } \
        else { s_k0 = ldg_b128(Kt, koffA); s_k1 = ldg_b128(Kt, koffB); \
               if constexpr (MODE == MODE_MLA) s_k2 = ldg_b128(Kg2 + kt * UW, k2off); } } while (0)
#define SWRITE(bf) do { LAS char* Vb_ = V_lds + (bf) * SHM_V; LAS char* Kb_ = K_lds + (bf) * SHM_K; \
        *(LAS bf16x8*)(Vb_ + vst0) = s_v0; *(LAS bf16x8*)(Vb_ + vst1) = s_v1; \
        if constexpr (MODE == MODE_DIFF) { *(LAS bf16x8*)(Kb_ + KSWZ64(sr64, sc64 * 2)) = s_k0; } \
        else { *(LAS bf16x8*)(Kb_ + KSWZ128(sr, sc * 2)) = s_k0; *(LAS bf16x8*)(Kb_ + KSWZ128(32 + sr, sc * 2)) = s_k1; \
               if constexpr (MODE == MODE_MLA) *(LAS bf16x8*)(Kb_ + 16384 + KSWZ64(sr64, sc64 * 2)) = s_k2; } } while (0)
#define RESC(a) do { if (__any((a) < 1.f)) { if (hi == 0) al_l[r32] = (a); asm volatile("s_waitcnt lgkmcnt(0)" ::: "memory"); \
        _Pragma("unroll") for (int d = 0; d < 4; ++d) _Pragma("unroll") for (int r = 0; r < 16; ++r) o[d][r] *= al_l[crow(r, hi)]; } } while (0)
#define NAMASK(pa_, pb_, t) do { if constexpr (MODE == MODE_NA) na_bias_mask(pa_, pb_, rpbL, kr_lo + (t), rq, qc, hi); } while (0)
        f32x16 p0, p1; float mn, al; bf16x8 pa0, pa1, pa2, pa3;
        if constexpr (HALF_OFFSET) {
        SLOAD(0); VM_WAIT(); SWRITE(0); SLOAD(1); __syncthreads();
        const int grp = __builtin_amdgcn_readfirstlane(wid) >> 2;
#pragma unroll 1
        for (int sl = 0; sl < 2 * NT + 1; ++sl) {
            if (sl & 1) { const int t = sl >> 1; if (t + 1 < NT) { VM_WAIT(); SWRITE((t + 1) & 1); } if (t + 2 < NT) SLOAD(t + 2); }
            SBAR();
            const int rel = sl - grp, tt = rel >> 1;
            if (rel >= 0 && tt < NT) {
                bool act = true;
                if constexpr (MODE == MODE_NA) { const int kr = kr_lo + tt, r0w = min(max(rq - 4, 0), 56); act = (kr >= r0w) && (kr < r0w + 8); }
                if (act) {
                    if ((rel & 1) == 0) { qkt<MODE>(p0, p1, K_lds + (tt & 1) * SHM_K, qr, r32, hi); NAMASK(p0, p1, tt); }
                    else { partialSM<MODE>(p0, p1, m_reg, mn, al);
                        RESC(al);
                        finishSM(p0, p1, al, l_reg, pa0, pa1, pa2, pa3); SBAR();
                        pv_d0(o, vb0 + (tt & 1) * SHM_V, pa0, pa1, pa2, pa3); }
                }
            }
            __syncthreads();
        }
        } else if constexpr (ATT_GLDS && ((ATT2 >> MODE) & 1) && MODE != MODE_NA) {
        unsigned gsv[2], gsk[2], gsk2 = 0u;
#pragma unroll
        for (int i = 0; i < 2; ++i) { const int a = (i * 512 + tid) * 16;
            { const int sub = a >> 9, within = a & 511; const int kk = (sub >> 2) * 8 + (within >> 6); const int k = (kk & ~0xC) | ((kk & 4) << 1) | ((kk & 8) >> 1);
              const int c = (sub & 3) * 32 + ((within & 63) >> 1); gsv[i] = (unsigned)(k * ldv + c) * 2u; }
            if constexpr (MODE == MODE_DIFF) { if (i == 0) { const int row = a >> 7, ch = ((a >> 4) & 7) ^ ((row >> 1) & 7); gsk[0] = (unsigned)(row * ldk + ch * 8) * 2u; } gsk[1] = 0u; }
            else { const int row = a >> 8, ch = ((a >> 4) & 15) ^ (row & 15); gsk[i] = (unsigned)(row * ldk + ch * 8) * 2u; } }
        if constexpr (MODE == MODE_MLA) { const int a = tid * 16, row = a >> 7, ch = ((a >> 4) & 7) ^ ((row >> 1) & 7); gsk2 = (unsigned)(row * UW + ch * 8) * 2u; }
        const unsigned ldsw = (unsigned)__builtin_amdgcn_readfirstlane(wid) * 1024u;
#define GLDS3(t) do { const int bf_ = (t) % 3; const size_t kt = (size_t)(kbase + (t) * 64); const char* Vt = (const char*)(Vg + kt * ldv); const char* Kt = (const char*)(Kp + kt * ldk); \
        LAS char* Vb_ = V_lds + bf_ * SHM_V + ldsw; LAS char* Kb_ = K_lds + bf_ * SHM_K + ldsw; \
        __builtin_amdgcn_global_load_lds((const unsigned*)(Vt + gsv[0]), (LAS unsigned*)(Vb_), 16, 0, 0); __builtin_amdgcn_global_load_lds((const unsigned*)(Vt + gsv[1]), (LAS unsigned*)(Vb_ + 8192), 16, 0, 0); \
        __builtin_amdgcn_global_load_lds((const unsigned*)(Kt + gsk[0]), (LAS unsigned*)(Kb_), 16, 0, 0); \
        if constexpr (MODE != MODE_DIFF) __builtin_amdgcn_global_load_lds((const unsigned*)(Kt + gsk[1]), (LAS unsigned*)(Kb_ + 8192), 16, 0, 0); \
        if constexpr (MODE == MODE_MLA) __builtin_amdgcn_global_load_lds((const unsigned*)((const char*)(Kg2 + kt * UW) + gsk2), (LAS unsigned*)(Kb_ + 16384), 16, 0, 0); } while (0)
#define KB3(t) (K_lds + ((t) % 3) * SHM_K)
#define VB3(t) (vb0 + ((t) % 3) * SHM_V)
        f32x16 pB0, pB1; float mnB, alB;
        GLDS3(0); GLDS3(1); VM_WAIT(); __syncthreads();
        qkt<MODE>(p0, p1, KB3(0), qr, r32, hi); partialSM<MODE>(p0, p1, m_reg, mn, al);
#pragma unroll 1
        for (int j = 1; j + 1 < NT; j += 2) {
            GLDS3(j + 1);
            SBAR(); qkt<MODE>(pB0, pB1, KB3(j), qr, r32, hi);
            finishSM(p0, p1, al, l_reg, pa0, pa1, pa2, pa3); SBAR();
            pv_d0(o, VB3(j - 1), pa0, pa1, pa2, pa3); partialSM<MODE>(pB0, pB1, m_reg, mnB, alB);
            RESC(alB); VM_WAIT(); __syncthreads();
            if (j + 2 < NT) GLDS3(j + 2);
            SBAR(); qkt<MODE>(p0, p1, KB3(j + 1), qr, r32, hi);
            finishSM(pB0, pB1, alB, l_reg, pa0, pa1, pa2, pa3); SBAR();
            pv_d0(o, VB3(j), pa0, pa1, pa2, pa3); partialSM<MODE>(p0, p1, m_reg, mn, al);
            RESC(al); VM_WAIT(); __syncthreads();
        }
        SBAR(); qkt<MODE>(pB0, pB1, KB3(NT - 1), qr, r32, hi);
        finishSM(p0, p1, al, l_reg, pa0, pa1, pa2, pa3); SBAR();
        pv_d0(o, VB3(NT - 2), pa0, pa1, pa2, pa3); partialSM<MODE>(pB0, pB1, m_reg, mnB, alB);
        RESC(alB);
        finishSM(pB0, pB1, alB, l_reg, pa0, pa1, pa2, pa3); SBAR();
        pv_d0(o, VB3(NT - 1), pa0, pa1, pa2, pa3);
        __syncthreads();
#undef GLDS3
#undef KB3
#undef VB3
        } else if constexpr (ATT_GLDS) {
        unsigned gsv[2], gsk[2], gsk2 = 0u;
#pragma unroll
        for (int i = 0; i < 2; ++i) { const int a = (i * 512 + tid) * 16;
            { const int sub = a >> 9, within = a & 511; const int kk = (sub >> 2) * 8 + (within >> 6); const int k = (kk & ~0xC) | ((kk & 4) << 1) | ((kk & 8) >> 1);
              const int c = (sub & 3) * 32 + ((within & 63) >> 1); gsv[i] = (unsigned)(k * ldv + c) * 2u; }
            if constexpr (MODE == MODE_DIFF) { if (i == 0) { const int row = a >> 7, ch = ((a >> 4) & 7) ^ ((row >> 1) & 7); gsk[0] = (unsigned)(row * ldk + ch * 8) * 2u; } gsk[1] = 0u; }
            else { const int row = a >> 8, ch = ((a >> 4) & 15) ^ (row & 15); gsk[i] = (unsigned)(row * ldk + ch * 8) * 2u; } }
        if constexpr (MODE == MODE_MLA) { const int a = tid * 16, row = a >> 7, ch = ((a >> 4) & 7) ^ ((row >> 1) & 7); gsk2 = (unsigned)(row * UW + ch * 8) * 2u; }
        const unsigned ldsw = (unsigned)__builtin_amdgcn_readfirstlane(wid) * 1024u;
#define GLDS(t, bf) do { const size_t kt = (size_t)(kbase + (t) * 64); const char* Vt = (const char*)(Vg + kt * ldv); const char* Kt = (const char*)(Kp + kt * ldk); \
        LAS char* Vb_ = V_lds + (bf) * SHM_V + ldsw; LAS char* Kb_ = K_lds + (bf) * SHM_K + ldsw; \
        __builtin_amdgcn_global_load_lds((const unsigned*)(Vt + gsv[0]), (LAS unsigned*)(Vb_), 16, 0, 0); __builtin_amdgcn_global_load_lds((const unsigned*)(Vt + gsv[1]), (LAS unsigned*)(Vb_ + 8192), 16, 0, 0); \
        __builtin_amdgcn_global_load_lds((const unsigned*)(Kt + gsk[0]), (LAS unsigned*)(Kb_), 16, 0, 0); \
        if constexpr (MODE != MODE_DIFF) __builtin_amdgcn_global_load_lds((const unsigned*)(Kt + gsk[1]), (LAS unsigned*)(Kb_ + 8192), 16, 0, 0); \
        if constexpr (MODE == MODE_MLA) __builtin_amdgcn_global_load_lds((const unsigned*)((const char*)(Kg2 + kt * UW) + gsk2), (LAS unsigned*)(Kb_ + 16384), 16, 0, 0); } while (0)
        GLDS(0, 0); VM_WAIT(); __syncthreads();
#pragma unroll 1
        for (int t = 0; t < NT; ++t) {
            const int bf = t & 1;
            if (t + 1 < NT) GLDS(t + 1, bf ^ 1);
            SBAR();
            bool act = true;
            if constexpr (MODE == MODE_NA) { const int kr = kr_lo + t, r0w = min(max(rq - 4, 0), 56); act = (kr >= r0w) && (kr < r0w + 8); }
            if (act) {
            qkt<MODE>(p0, p1, K_lds + bf * SHM_K, qr, r32, hi); NAMASK(p0, p1, t);
            partialSM<MODE>(p0, p1, m_reg, mn, al);
            RESC(al);
            finishSM(p0, p1, al, l_reg, pa0, pa1, pa2, pa3); SBAR();
            pv_d0(o, vb0 + bf * SHM_V, pa0, pa1, pa2, pa3);
            }
            VM_WAIT();
            __syncthreads();
        }
#undef GLDS
        } else {
        SLOAD(0); VM_WAIT(); SWRITE(0); SLOAD(1); __syncthreads();
#pragma unroll 1
        for (int t = 0; t < NT; ++t) {
            const int bf = t & 1;
            if (t + 1 < NT) { VM_WAIT(); SWRITE(bf ^ 1); }
            SBAR();
            bool act = true;
            if constexpr (MODE == MODE_NA) { const int kr = kr_lo + t, r0w = min(max(rq - 4, 0), 56); act = (kr >= r0w) && (kr < r0w + 8); }
            if (act) {
            qkt<MODE>(p0, p1, K_lds + bf * SHM_K, qr, r32, hi); NAMASK(p0, p1, t);
            partialSM<MODE>(p0, p1, m_reg, mn, al);
            RESC(al);
            finishSM(p0, p1, al, l_reg, pa0, pa1, pa2, pa3); SBAR();
            }
            if (t + 2 < NT) SLOAD(t + 2);
            SBAR();
            if (act) pv_d0(o, vb0 + bf * SHM_V, pa0, pa1, pa2, pa3);
            __syncthreads();
        }
        }
        int r32e = r32, hie = hi; asm volatile("" : "+v"(r32e), "+v"(hie));
        if (hi == 0) li_l[r32] = l_reg; asm volatile("s_waitcnt lgkmcnt(0)" ::: "memory");
#pragma unroll
        for (int r = 0; r < 16; ++r) { const float rl = __builtin_amdgcn_rcpf(li_l[crow(r, hie)]);
#pragma unroll
            for (int d0 = 0; d0 < 4; ++d0) o[d0][r] *= rl; }
        const int orow0 = tok0 + qb * 256 + __builtin_amdgcn_readfirstlane(wid) * 32;
        if constexpr (MODE == MODE_DIFF) {
            float* O1b = (pass == 0 ? P.O1 : P.O2) + (size_t)orow0 * 512 + h * 128;
            const unsigned o1off = (unsigned)(hie * 4 * 512 + r32e) * 4u;
#pragma unroll
            for (int r = 0; r < 16; ++r)
#pragma unroll
                for (int d0 = 0; d0 < 4; ++d0) stg_f32(O1b + crow(r, 0) * 512, o1off + (unsigned)(d0 * 128), o[d0][r]);
        } else {
            bf16* Mb = P.MIX + (size_t)orow0 * DM + ((MODE == MODE_MLA) ? h * 128 : 1024 + h * 128);
            const unsigned moff = (unsigned)(hie * 4 * DM + r32e) * 2u;
#pragma unroll
            for (int r = 0; r < 16; ++r)
#pragma unroll
                for (int d0 = 0; d0 < 4; ++d0) stg_u16(Mb + crow(r, 0) * DM, moff + (unsigned)(d0 * 64), (unsigned short)(cvt_pk_bf16(o[d0][r], 0.f) & 0xffffu));
        }
        __syncthreads();
#undef SLOAD
#undef SWRITE
#undef RESC
#undef NAMASK
    }
}
}

struct Args {
    const float* in[28]; float* out; unsigned char* ws; int ph_lo, ph_hi;
};
typedef const __attribute__((address_space(4))) unsigned char* kaptr;
struct KA {
    kaptr p;
    __device__ __forceinline__ const float* in(int i) const { return *(const float* const __attribute__((address_space(4)))*)(p + 8 * i); }
    __device__ __forceinline__ float* out() const { return *(float* const __attribute__((address_space(4)))*)(p + 224); }
    __device__ __forceinline__ unsigned char* ws() const { return *(unsigned char* const __attribute__((address_space(4)))*)(p + 232); }
    __device__ __forceinline__ int ph_lo() const { return *(const __attribute__((address_space(4))) int*)(p + 240); }
    __device__ __forceinline__ int ph_hi() const { return *(const __attribute__((address_space(4))) int*)(p + 244); }
};
__device__ __forceinline__ KA fresh_ka() { kaptr p = (kaptr)__builtin_amdgcn_kernarg_segment_ptr(); asm volatile("" : "+s"(p)); return KA{p}; }
static_assert(sizeof(Args) == 248, "Args layout");
struct Frame {
    LAS unsigned char* lds; volatile LAS unsigned* MISC; unsigned* ctl;
    int tid, lane, wave, G, gw, NGW;
};
constexpr int NPHASE = 2 + 8 * NLAYER;
#ifndef GEMM_SP2
#define GEMM_SP2 true
#endif
#ifndef CONV_QUOTA
#define CONV_QUOTA 7
#endif

struct CvtDesc { const float* src; unsigned char* dst; int N, dKB, f8; };
__device__ __forceinline__ void cvt_load(const CvtDesc& d, float (&t)[64], int lane) {
    const float* p = d.src + (size_t)(lane >> 4) * d.N + 4 * (lane & 15);
#pragma unroll
    for (int i = 0; i < 16; ++i) { const f32x4 v = __builtin_nontemporal_load((const f32x4*)(p + (size_t)(4 * i) * d.N));
        t[4 * i] = v.x; t[4 * i + 1] = v.y; t[4 * i + 2] = v.z; t[4 * i + 3] = v.w; }
}
__device__ __forceinline__ void cvt_finish(const CvtDesc& d, const float (&t)[64], LAS float* scr, int lane) {
    LAS float* sw = scr + (lane >> 4) * 65 + 4 * (lane & 15);
#pragma unroll
    for (int i = 0; i < 16; ++i) { sw[(4 * i) * 65] = t[4 * i]; sw[(4 * i) * 65 + 1] = t[4 * i + 1]; sw[(4 * i) * 65 + 2] = t[4 * i + 2]; sw[(4 * i) * 65 + 3] = t[4 * i + 3]; }
    LDS_WAIT();
    const int c = lane & 7;
    if (d.f8) {
#pragma unroll
        for (int j = 0; j < 8; ++j) { const int n = (lane >> 3) + 8 * j; const LAS float* s = scr + (8 * c) * 65 + n;
            int a = __builtin_amdgcn_cvt_pk_fp8_f32(clamp8(s[0 * 65] * W8_SCALE), clamp8(s[1 * 65] * W8_SCALE), 0, false); a = __builtin_amdgcn_cvt_pk_fp8_f32(clamp8(s[2 * 65] * W8_SCALE), clamp8(s[3 * 65] * W8_SCALE), a, true);
            int b = __builtin_amdgcn_cvt_pk_fp8_f32(clamp8(s[4 * 65] * W8_SCALE), clamp8(s[5 * 65] * W8_SCALE), 0, false); b = __builtin_amdgcn_cvt_pk_fp8_f32(clamp8(s[6 * 65] * W8_SCALE), clamp8(s[7 * 65] * W8_SCALE), b, true);
            __builtin_nontemporal_store((u32x2){(unsigned)a, (unsigned)b}, (u32x2*)(d.dst + (size_t)n * d.dKB + 8 * c)); }
    } else {
#pragma unroll
        for (int j = 0; j < 8; ++j) { const int n = (lane >> 3) + 8 * j; const LAS float* s = scr + (8 * c) * 65 + n;
            u32x4 o; o.x = cvt_pk_bf16(s[0 * 65], s[1 * 65]); o.y = cvt_pk_bf16(s[2 * 65], s[3 * 65]); o.z = cvt_pk_bf16(s[4 * 65], s[5 * 65]); o.w = cvt_pk_bf16(s[6 * 65], s[7 * 65]);
            __builtin_nontemporal_store(o, (u32x4*)(d.dst + (size_t)n * d.dKB + 16 * c)); }
    }
    LDS_WAIT();
}
__device__ __forceinline__ void cvt_item(const float* W, int N, int k0, int n0, bf16* WT, size_t dst_row0, int dK, LAS float* scr, int lane) {
    CvtDesc d; d.src = W + (size_t)k0 * N + n0; d.dst = (unsigned char*)(WT + dst_row0 * dK + k0); d.N = N; d.dKB = dK * 2; d.f8 = 0;
    float t[64]; cvt_load(d, t, lane); cvt_finish(d, t, scr, lane);
}

__device__ __forceinline__ void sincos_rev(double t, float& c, float& s) {
    const int q = (int)(t * 4.0 + 0.5);
    const double r = (t - 0.25 * q) * 6.283185307179586476925;
    const double r2 = r * r;
    const double sn = r * (1.0 + r2 * (-1.0 / 6 + r2 * (1.0 / 120 + r2 * (-1.0 / 5040 + r2 * (1.0 / 362880 + r2 * (-1.0 / 39916800 + r2 * (1.0 / 6227020800.0)))))));
    const double cs = 1.0 + r2 * (-0.5 + r2 * (1.0 / 24 + r2 * (-1.0 / 720 + r2 * (1.0 / 40320 + r2 * (-1.0 / 3628800 + r2 * (1.0 / 479001600.0 + r2 * (-1.0 / 87178291200.0)))))));
    double co, si;
    switch (q & 3) { case 0: co = cs; si = sn; break; case 1: co = -sn; si = cs; break; case 2: co = -cs; si = -sn; break; default: co = sn; si = -cs; break; }
    c = (float)co; s = (float)si;
}

__device__ __forceinline__ void row_stats(const f32x4 (&v)[8], float& mean, float& rstd) {
    float s = 0.f;
#pragma unroll
    for (int j = 0; j < 8; ++j) s += (v[j].x + v[j].y) + (v[j].z + v[j].w);
    mean = wave_sum(s) * (1.f / DM);
    float s2 = 0.f;
#pragma unroll
    for (int j = 0; j < 8; ++j) { const f32x4 d = v[j] - mean; s2 += (d.x * d.x + d.y * d.y) + (d.z * d.z + d.w * d.w); }
    rstd = rsqrtf(wave_sum(s2) * (1.f / DM) + LN_EPS);
}

constexpr int CW_Q = 32768;
constexpr int Q_IG = NE1 * 256, Q_PER_L = 3 * Q_IG, Q_TOTAL = NLAYER * Q_PER_L;
__device__ __forceinline__ CvtDesc conv_expert_desc(const KA& a, unsigned char* ws, int q) {
    const int l = q / Q_PER_L; int r = q - l * Q_PER_L;
    unsigned char* wl = ws + WS_W + (size_t)l * W_LSTRIDE;
    CvtDesc d; d.f8 = (MOE_FP8_LAST && (MOE_FP8_GU_ALL || l == NLAYER - 1)) ? 1 : 0;
    if (MOE_FP8_LAST && MOE_FP8_DOWN_ALL && r >= 2 * Q_IG) d.f8 = 1;
    const int eb = d.f8 ? 1 : 2;
    if (r < 2 * Q_IG) { const int up = r >= Q_IG; if (up) r -= Q_IG; const int e = r >> 8, rr = r & 255, kb = rr >> 3, nb = rr & 7, n0 = nb * 64;
        const float* src = e < 64 ? a.in(up ? 21 : 20) + ((size_t)l * 64 + e) * DM * FFE : a.in(up ? 24 : 23) + (size_t)l * DM * FFE;
        d.src = src + (size_t)(kb * 64) * FFE + n0; d.N = FFE; d.dKB = DM * eb;
        d.dst = wl + W_GU + ((size_t)e * 1024 * DM + (size_t)((n0 >> 7) * 256 + up * 128 + (n0 & 127)) * DM + kb * 64) * eb;
    } else { r -= 2 * Q_IG; const int e = r >> 8, rr = r & 255, kb = rr >> 5, nb = rr & 31;
        const float* src = e < 64 ? a.in(22) + ((size_t)l * 64 + e) * FFE * DM : a.in(25) + (size_t)l * FFE * DM;
        d.src = src + (size_t)(kb * 64) * DM + nb * 64; d.N = DM; d.dKB = FFE * eb;
        d.dst = wl + W_D + ((size_t)e * DM * FFE + (size_t)(nb * 64) * FFE + kb * 64) * eb; }
    return d;
}
__device__ __forceinline__ void conv_expert_item(const KA& a, unsigned char* ws, int q, LAS float* scr, int lane) {
    const CvtDesc d = conv_expert_desc(a, ws, q); float t[64]; cvt_load(d, t, lane); cvt_finish(d, t, scr, lane);
}
__device__ __forceinline__ void conv_drain(const KA& a, unsigned char* ws, LAS unsigned char* lds, int target, int max_claims = 0x7fffffff) {
    volatile LAS unsigned* st = (volatile LAS unsigned*)(lds + MISC_OFF) + 8;
    unsigned* qw = (unsigned*)(ws + WS_CTL) + CW_Q;
    int tl = tid_x(); asm volatile("" : "+v"(tl));
    const int wave = __builtin_amdgcn_readfirstlane(tl >> 6), lane = tl & 63;
    LAS float* scr = (LAS float*)(lds + wave * 16640);
    __syncthreads();
    unsigned ahead = 0xFFFFFFFFu;
    if (tl == 0 && max_claims > 0) { if (xb_ld(qw) < (unsigned)target) ahead = xb_add(qw, 32u); }
    for (int nc = 0; nc < max_claims; ++nc) {
        if (tl == 0) { st[6] = ahead; if (ahead < (unsigned)target && nc + 1 < max_claims) ahead = (ahead + 32u < (unsigned)target) ? xb_add(qw, 32u) : 0xFFFFFFFFu; }
        __syncthreads();
        const unsigned base = st[6];
        if (base < (unsigned)Q_TOTAL) {
            const int q0 = (int)base + wave; const bool v0 = q0 < Q_TOTAL, v1 = q0 + 8 < Q_TOTAL, v2 = q0 + 16 < Q_TOTAL, v3 = q0 + 24 < Q_TOTAL;
            float ta[64], tb[64]; CvtDesc da, db;
            if (v0) { da = conv_expert_desc(a, ws, q0); cvt_load(da, ta, lane); }
            if (v1) { db = conv_expert_desc(a, ws, q0 + 8); cvt_load(db, tb, lane); }
            if (v0) cvt_finish(da, ta, scr, lane);
            if (v2) { da = conv_expert_desc(a, ws, q0 + 16); cvt_load(da, ta, lane); }
            if (v1) cvt_finish(db, tb, scr, lane);
            if (v3) { db = conv_expert_desc(a, ws, q0 + 24); cvt_load(db, tb, lane); }
            if (v2) cvt_finish(da, ta, scr, lane);
            if (v3) cvt_finish(db, tb, scr, lane);
        }
        if (base >= (unsigned)target) break;
        __syncthreads();
    }
    __syncthreads();
}
__device__ __forceinline__ void xcd_barrier_work(const XcdBarrier& b, const KA& a, unsigned char* ws, LAS unsigned char* lds) {
    asm volatile("s_waitcnt vmcnt(0)" ::: "memory");
    __syncthreads();
    volatile LAS unsigned* st = b.st;
    unsigned* bar = b.bar; asm volatile("" : "+s"(bar));
    unsigned* qw = (unsigned*)(ws + WS_CTL) + CW_Q;
    if (tid_x() == 0) {
        __builtin_amdgcn_s_waitcnt(0);
        unsigned nloc = st[0], nx = st[1];
        if (nloc == 0u) { xcd_barrier_complete(bar, b.x, nloc, nx); st[0] = nloc; st[1] = nx; }
        const unsigned old = xb_add(&bar[XB_XSUB(b.x)], 1u);
        const unsigned gen = old / nloc;
        if (old + 1u == (gen + 1u) * nloc) {
            __builtin_amdgcn_fence(__ATOMIC_RELEASE, "agent");
            asm volatile("s_waitcnt vmcnt(0)" ::: "memory");
            const unsigned og = xb_add(&bar[XB_TOP], 1u);
            const unsigned tg = og / nx;
            if (og + 1u == (tg + 1u) * nx) xb_add(&bar[XB_TOPGEN], 1u);
            else XB_SPIN(xb_ld(&bar[XB_TOPGEN]) == tg, bar);
            __builtin_amdgcn_fence(__ATOMIC_ACQUIRE, "agent");
            xb_add(&bar[XB_XGEN(b.x)], 1u);
            asm volatile("s_waitcnt vmcnt(0)" ::: "memory");
            st[4] = 1u;
        } else { st[4] = 0u; st[5] = gen; }
    }
    __syncthreads();
    int tl = tid_x(); asm volatile("" : "+v"(tl));
    const int wave = __builtin_amdgcn_readfirstlane(tl >> 6), lane = tl & 63;
    LAS float* scr = (LAS float*)(lds + wave * 16640);
    unsigned spins = 0;
    while (st[4] == 0u) {
        if (tl == 0) {
            if (xb_ld(&bar[XB_XGEN(b.x)]) != st[5] || xb_ld(&bar[XB_TMO]) != 0u) {
                __builtin_amdgcn_fence(__ATOMIC_ACQUIRE, "agent");
                asm volatile("s_waitcnt vmcnt(0)" ::: "memory");
                st[4] = 1u;
            } else {
                if (++spins > XB_SPIN_CAP) atomicAdd(&bar[XB_TMO], 1u);
                unsigned base = 0xFFFFFFFFu;
                if (st[7] == 0u) { base = xb_add(qw, 8u); if (base >= (unsigned)Q_TOTAL) st[7] = 1u; }
                st[6] = base;
            }
        }
        __syncthreads();
        if (st[4] != 0u) break;
        const unsigned base = st[6];
        if (base < (unsigned)Q_TOTAL) { if (base + wave < (unsigned)Q_TOTAL) conv_expert_item(a, ws, (int)base + wave, scr, lane); }
        else __builtin_amdgcn_s_sleep(4);
        __syncthreads();
    }
    __syncthreads();
}

__device__ __forceinline__ void p0_prologue(Frame& F, const KA& a) {
    unsigned char* ws = a.ws();
    {
        LAS float* sc = (LAS float*)F.lds; LAS float* red = (LAS float*)(F.lds + 16384);
        const float* cin = a.in(1);
        for (int idx = F.tid; idx < 2 * DM; idx += 512) { const float cv = cin[idx]; sc[idx] = cv * __builtin_amdgcn_rcpf(1.f + __builtin_amdgcn_exp2f(-1.4426950408889634f * cv)); }
        __syncthreads();
        for (int task = blockIdx.x; task < 256; task += F.G) {
            const int l = task >> 7, c0 = (task & 127) * 96;
            const float* Wp = a.in(2) + (size_t)l * DM * ADA_W + c0 + F.lane;
            const bool two = F.lane < 32;
            float a00 = 0.f, a01 = 0.f, a10 = 0.f, a11 = 0.f;
            const int kb = F.wave * 256;
#pragma unroll 1
            for (int k0 = 0; k0 < 256; k0 += 32) {
                float w0[32], w1[32];
#pragma unroll
                for (int k = 0; k < 32; ++k) { w0[k] = __builtin_nontemporal_load(Wp + (size_t)(kb + k0 + k) * ADA_W); w1[k] = two ? __builtin_nontemporal_load(Wp + (size_t)(kb + k0 + k) * ADA_W + 64) : 0.f; }
#pragma unroll
                for (int k = 0; k < 32; ++k) { const float s0 = sc[kb + k0 + k], s1 = sc[DM + kb + k0 + k];
                    a00 = fmaf(s0, w0[k], a00); a01 = fmaf(s0, w1[k], a01); a10 = fmaf(s1, w0[k], a10); a11 = fmaf(s1, w1[k], a11); }
            }
            red[(F.wave * 2 + 0) * 96 + F.lane] = a00; red[(F.wave * 2 + 1) * 96 + F.lane] = a10;
            if (two) { red[(F.wave * 2 + 0) * 96 + 64 + F.lane] = a01; red[(F.wave * 2 + 1) * 96 + 64 + F.lane] = a11; }
            __syncthreads();
            if (F.tid < 192) { const int b = F.tid / 96, j = F.tid % 96; float s = 0.f;
#pragma unroll
                for (int w = 0; w < 8; ++w) s += red[(w * 2 + b) * 96 + j];
                ((float*)(ws + WS_ADA))[(size_t)(l * 2 + b) * ADA_W + c0 + j] = s + a.in(3)[(size_t)l * ADA_W + c0 + j]; }
            __syncthreads();
        }
    }
    {
        f32x2* rm = (f32x2*)(ws + WS_ROPEM); f32x2* rd = (f32x2*)(ws + WS_ROPED);
        for (int idx = blockIdx.x * 512 + F.tid; idx < SEQ * 40; idx += F.G * 512) {
            const int pos = idx / 40, j = idx % 40;
            const int jj = j < 32 ? j : j - 32; const double base = j < 32 ? 0.66360123769608848 : 0.19392274474868576;
            double inv = 1.0; for (int q = 0; q < jj; ++q) inv *= base;
            double t = (double)pos * inv * 0.15915494309189533577; t -= floor(t);
            float c, s; sincos_rev(t, c, s);
            if (j < 32) rm[pos * 32 + j] = (f32x2){c, s}; else rd[pos * 8 + jj] = (f32x2){c, s};
        }
    }
    {
        LAS float* scr = (LAS float*)(F.lds + F.wave * 16640);
        constexpr int I_IN = 32 * 61, I_UQ = 8 * 24, I_UKV = 4 * 32, I_O = 32 * 32, I_R = 32;
        constexpr int PER_L = I_IN + I_UQ + I_UKV + I_O + I_R;
        for (int it = F.gw; it < NLAYER * PER_L; it += F.NGW) {
            const int l = it / PER_L; int r = it - l * PER_L;
            unsigned char* wl = ws + WS_W + (size_t)l * W_LSTRIDE;
            if (r < I_IN) { const int kb = r / 61, nb = r % 61, n0 = nb * 64; const int d0 = n0 < 832 ? n0 : n0 + 192;
                cvt_item(a.in(4) + (size_t)l * DM * 3904, 3904, kb * 64, n0, (bf16*)(wl + W_IN), d0, DM, scr, F.lane); continue; } r -= I_IN;
            if (r < I_UQ) { const int kb = r / 24, nb = r % 24;
                cvt_item(a.in(6) + (size_t)l * 512 * 1536, 1536, kb * 64, nb * 64, (bf16*)(wl + W_UQ), nb * 64, 512, scr, F.lane); continue; } r -= I_UQ;
            if (r < I_UKV) { const int kb = r / 32, nb = r % 32;
                cvt_item(a.in(8) + (size_t)l * 256 * 2048, 2048, kb * 64, nb * 64, (bf16*)(wl + W_UKV), nb * 64, 256, scr, F.lane); continue; } r -= I_UKV;
            if (r < I_O) { const int kb = r / 32, nb = r % 32;
                cvt_item(a.in(15) + (size_t)l * DM * DM, DM, kb * 64, nb * 64, (bf16*)(wl + W_O), nb * 64, DM, scr, F.lane); continue; } r -= I_O;
            cvt_item(a.in(18) + (size_t)l * DM * 64, 64, r * 64, 0, (bf16*)(wl + W_R), 0, DM, scr, F.lane);
        }
        for (int l = 0; l < NLAYER; ++l) { u32x4* z = (u32x4*)(ws + WS_W + (size_t)l * W_LSTRIDE + W_IN + (size_t)832 * DM * 2);
            for (int i = blockIdx.x * 512 + F.tid; i < 192 * DM * 2 / 16; i += F.G * 512) z[i] = (u32x4){0u, 0u, 0u, 0u}; }
    }
}

__device__ __forceinline__ void ln_mod_row(const float* xrow, const float* sh, const float* sc, bf16* hrow, int lane) {
    f32x4 v[8];
#pragma unroll
    for (int j = 0; j < 8; ++j) v[j] = *(const f32x4*)(xrow + 4 * lane + 256 * j);
    float mean, rstd; row_stats(v, mean, rstd);
#pragma unroll
    for (int j = 0; j < 8; ++j) { const f32x4 s1 = *(const f32x4*)(sc + 4 * lane + 256 * j) + 1.0f, s0 = *(const f32x4*)(sh + 4 * lane + 256 * j);
        const f32x4 y = (v[j] - mean) * rstd * s1 + s0;
        u32x2 w; w.x = cvt_pk_bf16(y.x, y.y); w.y = cvt_pk_bf16(y.z, y.w); st_wt8(hrow + 4 * lane + 256 * j, w); }
}

__device__ __forceinline__ void post_u_row(bf16* urow, int pos, const float* gq, const float* gkv, const f32x2* ropeM, const f32x2* ropeD, int lane) {
    u32x4 wq = *(u32x4*)(urow + U_CQ + 8 * lane);
    u32x2 wk = *(u32x2*)(urow + U_CKV + 4 * lane);
    const int lr = lane & 31;
    const unsigned short kra = *(const unsigned short*)(urow + U_KR + lr), krc = *(const unsigned short*)(urow + U_KR + 32 + lr);
    const f32x2 csk = ropeM[(size_t)pos * 32 + lr];
    unsigned short da[2], dc[2]; f32x2 csd[2];
#pragma unroll
    for (int t = 0; t < 2; ++t) { const int pi = lane + 64 * t, blk = pi >> 3, j = pi & 7; const bf16* p = urow + U_DF + blk * 64 + j;
        da[t] = *(const unsigned short*)(p); dc[t] = *(const unsigned short*)(p + 8); csd[t] = ropeD[(size_t)pos * 8 + j]; }
    const f32x4 g0 = *(const f32x4*)(gq + 8 * lane), g1 = *(const f32x4*)(gq + 8 * lane + 4), gk = *(const f32x4*)(gkv + 4 * lane);
    asm volatile("" ::: "memory");
    {
        float x[8] = {bflo(wq.x), bfhi(wq.x), bflo(wq.y), bfhi(wq.y), bflo(wq.z), bfhi(wq.z), bflo(wq.w), bfhi(wq.w)};
        float ss = 0.f;
#pragma unroll
        for (int i = 0; i < 8; ++i) ss += x[i] * x[i];
        const float rs = rsqrtf(wave_sum(ss) * (1.f / 512.f) + RMS_EPS);
        wq.x = cvt_pk_bf16(x[0] * rs * g0.x, x[1] * rs * g0.y); wq.y = cvt_pk_bf16(x[2] * rs * g0.z, x[3] * rs * g0.w);
        wq.z = cvt_pk_bf16(x[4] * rs * g1.x, x[5] * rs * g1.y); wq.w = cvt_pk_bf16(x[6] * rs * g1.z, x[7] * rs * g1.w);
    }
    {
        float x[4] = {bflo(wk.x), bfhi(wk.x), bflo(wk.y), bfhi(wk.y)};
        const float ss = x[0] * x[0] + x[1] * x[1] + x[2] * x[2] + x[3] * x[3];
        const float rs = rsqrtf(wave_sum(ss) * (1.f / 256.f) + RMS_EPS);
        wk.x = cvt_pk_bf16(x[0] * rs * gk.x, x[1] * rs * gk.y); wk.y = cvt_pk_bf16(x[2] * rs * gk.z, x[3] * rs * gk.w);
    }
    *(u32x4*)(urow + U_CQ + 8 * lane) = wq;
    *(u32x2*)(urow + U_CKV + 4 * lane) = wk;
    if (lane < 32) {
        const float a = bf2f(kra), c = bf2f(krc);
        urow[U_KR + lane] = (bf16)(cvt_pk_bf16(a * csk.x - c * csk.y, 0.f) & 0xffffu);
        urow[U_KR + 32 + lane] = (bf16)(cvt_pk_bf16(c * csk.x + a * csk.y, 0.f) & 0xffffu);
    }
#pragma unroll
    for (int t = 0; t < 2; ++t) {
        const int pi = lane + 64 * t, blk = pi >> 3, j = pi & 7;
        bf16* p = urow + U_DF + blk * 64 + j;
        const float a = bf2f(da[t]), c = bf2f(dc[t]);
        p[0] = (bf16)(cvt_pk_bf16(a * csd[t].x - c * csd[t].y, 0.f) & 0xffffu);
        p[8] = (bf16)(cvt_pk_bf16(c * csd[t].x + a * csd[t].y, 0.f) & 0xffffu);
    }
}

__device__ __forceinline__ void diff_combine_row(const float* o1, const float* o2, bf16* mrow, float lam, const float* subln, float omli, int lane) {
    const f32x2 g = *(const f32x2*)(subln + 2 * lane);
    f32x2 av[4], cv[4];
#pragma unroll
    for (int h = 0; h < 4; ++h) { av[h] = __builtin_nontemporal_load((const f32x2*)(o1 + h * 128 + 2 * lane)); cv[h] = __builtin_nontemporal_load((const f32x2*)(o2 + h * 128 + 2 * lane)); }
    asm volatile("" ::: "memory");
#pragma unroll
    for (int h = 0; h < 4; ++h) {
        const f32x2 a = av[h], c = cv[h];
        const f32x2 d = a - c * lam;
        const float rs = rsqrtf(wave_sum(d.x * d.x + d.y * d.y) * (1.f / 128.f) + RMS_EPS);
        *(unsigned*)(mrow + 1536 + h * 128 + 2 * lane) = cvt_pk_bf16(d.x * rs * g.x * omli, d.y * rs * g.y * omli);
    }
}

__device__ __forceinline__ void p6_tile(Frame& F, const KA& a, int l, int tile) {
    unsigned char* ws = a.ws();
    constexpr int HS = 4112;
    LAS unsigned char* hT = F.lds; LAS float* LG = (LAS float*)(F.lds + 132096);
    const float* Y = (const float*)(ws + WS_Y); float* X1 = (float*)(ws + WS_X1); bf16* H = (bf16*)(ws + WS_H);
    const float* g1 = a.in(16) + (size_t)l * DM; const float* b1 = a.in(17) + (size_t)l * DM;
    const int row0 = tile * 32; const int b = row0 >> 12;
    const float* ada = (const float*)(ws + WS_ADA) + (size_t)(l * 2 + b) * ADA_W;
    const float* shf = ada + 3 * DM; const float* scf = ada + 4 * DM;
    f32x4 vn[8];
#pragma unroll
    for (int j = 0; j < 8; ++j) vn[j] = __builtin_nontemporal_load((const f32x4*)(Y + (size_t)(row0 + F.wave * 4) * DM + 4 * F.lane + 256 * j));
#pragma unroll 1
    for (int rr = 0; rr < 4; ++rr) {
        const int lr = F.wave * 4 + rr, row = row0 + lr;
        f32x4 v[8];
#pragma unroll
        for (int j = 0; j < 8; ++j) v[j] = vn[j];
        if (rr < 3) {
#pragma unroll
            for (int j = 0; j < 8; ++j) vn[j] = __builtin_nontemporal_load((const f32x4*)(Y + (size_t)(row + 1) * DM + 4 * F.lane + 256 * j));
        }
        float mean, rstd; row_stats(v, mean, rstd);
#pragma unroll
        for (int j = 0; j < 8; ++j) { const f32x4 g = *(const f32x4*)(g1 + 4 * F.lane + 256 * j), bb = *(const f32x4*)(b1 + 4 * F.lane + 256 * j);
            v[j] = (v[j] - mean) * rstd * g + bb; __builtin_nontemporal_store(v[j], (f32x4*)(X1 + (size_t)row * DM + 4 * F.lane + 256 * j)); }
        row_stats(v, mean, rstd);
#pragma unroll
        for (int j = 0; j < 8; ++j) { const f32x4 s1 = *(const f32x4*)(scf + 4 * F.lane + 256 * j) + 1.0f, s0 = *(const f32x4*)(shf + 4 * F.lane + 256 * j);
            const f32x4 y = (v[j] - mean) * rstd * s1 + s0;
            u32x2 w; w.x = cvt_pk_bf16(y.x, y.y); w.y = cvt_pk_bf16(y.z, y.w);
            if (MOE_FP8_LAST && (MOE_FP8_GU_ALL || l == NLAYER - 1)) { int q8 = __builtin_amdgcn_cvt_pk_fp8_f32(clamp8(y.x), clamp8(y.y), 0, false); q8 = __builtin_amdgcn_cvt_pk_fp8_f32(clamp8(y.z), clamp8(y.w), q8, true);
                st_wt4((unsigned char*)H + (size_t)row * DM + 4 * F.lane + 256 * j, (unsigned)q8); }
            else *(u32x2*)(H + (size_t)row * DM + 4 * F.lane + 256 * j) = w;
            *(LAS u32x2*)(hT + lr * HS + (4 * F.lane + 256 * j) * 2) = w; }
    }
    __syncthreads();
    {
        const int mt = F.wave >> 2, nt = F.wave & 3, fr = F.lane & 15, fq = F.lane >> 4;
        const bf16* Wr = (const bf16*)(ws + WS_W + (size_t)l * W_LSTRIDE + W_R) + (size_t)(nt * 16 + fr) * DM + fq * 8;
        const LAS unsigned char* ap = hT + (mt * 16 + fr) * HS + fq * 16;
        f32x4 acc = {0.f, 0.f, 0.f, 0.f};
#pragma unroll 8
        for (int ks = 0; ks < 64; ++ks) { const bf16x8 av = *(const LAS bf16x8*)(ap + ks * 64); const bf16x8 bv = *(const bf16x8*)(Wr + ks * 32);
            acc = __builtin_amdgcn_mfma_f32_16x16x32_bf16(av, bv, acc, 0, 0, 0); }
#pragma unroll
        for (int i = 0; i < 4; ++i) LG[(mt * 16 + fq * 4 + i) * 64 + nt * 16 + fr] = acc[i];
    }
    __syncthreads();
    {
        const float bias = a.in(19)[(size_t)l * 64 + F.lane];
        unsigned* cnt = (unsigned*)(ws + WS_CTL) + CW_CNT + l * 4096;
        int* list = (int*)(ws + WS_LIST); int* tokslot = (int*)(ws + WS_TOKSLOT); float* tokw = (float*)(ws + WS_TOKW);
        int rk[4]; float wq[4]; unsigned ps[4];
#pragma unroll
        for (int rr = 0; rr < 4; ++rr) {
            const int lr = F.wave * 4 + rr;
            const float lg = LG[lr * 64 + F.lane];
            const float sg = 1.f / (1.f + __expf(-lg));
            const float bs = sg + bias;
            float m1 = bs;
#pragma unroll
            for (int o = 1; o < 8; o <<= 1) m1 = fmaxf(m1, shfl_idx(m1, F.lane ^ o));
            const unsigned long long eq = __ballot(bs == m1);
            const int gbase = F.lane & ~7;
            const unsigned gm = (unsigned)((eq >> gbase) & 0xffull);
            const int first = gbase + __builtin_ctz(gm);
            float m2 = (F.lane == first) ? -__builtin_huge_valf() : bs;
#pragma unroll
            for (int o = 1; o < 8; o <<= 1) m2 = fmaxf(m2, shfl_idx(m2, F.lane ^ o));
            const float gs = m1 + m2; const int g = F.lane >> 3;
            int grank = 0;
#pragma unroll
            for (int q = 0; q < 8; ++q) { const float og = shfl_idx(gs, q * 8); grank += (og > gs || (og == gs && q < g)) ? 1 : 0; }
            const float val = (grank < 4) ? bs : -__builtin_huge_valf();
            int rank = 0;
#pragma unroll 8
            for (int q = 0; q < 64; ++q) { const float ov = shfl_idx(val, q); rank += (ov > val || (ov == val && q < F.lane)) ? 1 : 0; }
            const bool sel = rank < 8;
            const float wsum = wave_sum(sel ? sg : 0.f);
            rk[rr] = sel ? rank : -1; wq[rr] = sg / wsum * 2.5f;
        }
#pragma unroll
        for (int rr = 0; rr < 4; ++rr) ps[rr] = (rk[rr] >= 0) ? atomicAdd(cnt + 64 * F.lane, 1u) : 0u;
#pragma unroll
        for (int rr = 0; rr < 4; ++rr) if (rk[rr] >= 0) { const int tok = row0 + F.wave * 4 + rr;
            list[F.lane * 8192 + ps[rr]] = tok;
            tokslot[tok * 8 + rk[rr]] = (F.lane << 16) | (int)ps[rr];
            tokw[tok * 8 + rk[rr]] = wq[rr]; }
    }
    __syncthreads();
}

__device__ __forceinline__ void moe_tables(Frame& F, const KA& a, int l, LAS int* pref, LAS int* cntL) {
    const unsigned* cnt = (const unsigned*)(a.ws() + WS_CTL) + CW_CNT + l * 4096;
    if (F.tid < 64) cntL[F.tid] = (int)__hip_atomic_load(cnt + 64 * F.tid, RLX_AGENT);
    if (F.tid == 64) cntL[64] = NTOK;
    __syncthreads();
    if (F.tid < 64) {
        const int nt_e = (cntL[F.tid] + 255) >> 8; int inc = nt_e;
#pragma unroll
        for (int o = 1; o < 64; o <<= 1) { const int up = __builtin_amdgcn_ds_bpermute(((F.tid - o) & 63) << 2, inc); if (F.tid >= o) inc += up; }
        pref[F.tid] = inc - nt_e;
        if (F.tid == 63) { pref[64] = inc; pref[NE1] = inc + (NTOK >> 8); }
    }
    __syncthreads();
    if (F.tid < NE1) { const int t0 = pref[F.tid], t1 = pref[F.tid + 1]; for (int t = t0; t < t1; ++t) pref[400 + t] = F.tid; }
    __syncthreads();
}

__device__ __forceinline__ void p9_row(const KA& a, int l, int row, const LAS int* pref, int lane, int ts_l, float w_l) {
    unsigned char* ws = a.ws();
    const unsigned char* YS = ws + WS_YS; const float* X1 = (const float*)(ws + WS_X1);
    const int b = row >> 12;
    const float* ada = (const float*)(ws + WS_ADA) + (size_t)(l * 2 + b) * ADA_W;
    const float* gf = ada + 5 * DM;
    f32x4 m[8];
#pragma unroll
    for (int j = 0; j < 8; ++j) m[j] = (f32x4){0.f, 0.f, 0.f, 0.f};
    int slot_l = (lane < 8) ? pref[ts_l >> 16] * 256 + (ts_l & 0xffff) : pref[64] * 256 + row;
    if (lane >= 8) w_l = 1.f;
    w_l *= (1.f / YS_SCALE);
    const __amdgpu_buffer_rsrc_t yrs = __builtin_amdgcn_make_buffer_rsrc((void*)YS, 0, (unsigned)((size_t)SLOT_MAX * DM), 0x00020000);
    const int voff = 4 * lane;
    int yv[8][8], ys[8];
#pragma unroll
    for (int k = 0; k < 8; ++k) { const int soff = __builtin_amdgcn_readlane(slot_l, k) * DM;
#pragma unroll
        for (int j = 0; j < 8; ++j) yv[k][j] = __builtin_amdgcn_raw_buffer_load_b32(yrs, voff + 256 * j, soff, 2); }
#pragma unroll
    for (int k = 0; k < 8; ++k) { const float w = __builtin_bit_cast(float, __builtin_amdgcn_readlane(__builtin_bit_cast(int, w_l), k));
        if (k == 0) { const int soff = __builtin_amdgcn_readlane(slot_l, 8) * DM;
#pragma unroll
            for (int j = 0; j < 8; ++j) ys[j] = __builtin_amdgcn_raw_buffer_load_b32(yrs, voff + 256 * j, soff, 2); }
#pragma unroll
        for (int j = 0; j < 8; ++j) { const f32x2 lo = __builtin_amdgcn_cvt_pk_f32_fp8(yv[k][j], false), hi = __builtin_amdgcn_cvt_pk_f32_fp8(yv[k][j], true);
            m[j].x = fmaf(w, lo.x, m[j].x); m[j].y = fmaf(w, lo.y, m[j].y); m[j].z = fmaf(w, hi.x, m[j].z); m[j].w = fmaf(w, hi.y, m[j].w); } }
    { const float w = 1.f / YS_SCALE;
#pragma unroll
        for (int j = 0; j < 8; ++j) { const f32x2 lo = __builtin_amdgcn_cvt_pk_f32_fp8(ys[j], false), hi = __builtin_amdgcn_cvt_pk_f32_fp8(ys[j], true);
            m[j].x = fmaf(w, lo.x, m[j].x); m[j].y = fmaf(w, lo.y, m[j].y); m[j].z = fmaf(w, hi.x, m[j].z); m[j].w = fmaf(w, hi.y, m[j].w); } }
    asm volatile("" ::: "memory");
    f32x4 v[8];
#pragma unroll
    for (int j = 0; j < 8; ++j) { const f32x4 x1 = __builtin_nontemporal_load((const f32x4*)(X1 + (size_t)row * DM + 4 * lane + 256 * j)), g = *(const f32x4*)(gf + 4 * lane + 256 * j) + 1.0f;
        v[j] = x1 * DN_ALPHA + g * m[j]; }
    float mean, rstd; row_stats(v, mean, rstd);
    const float* g2 = a.in(26) + (size_t)l * DM; const float* b2 = a.in(27) + (size_t)l * DM;
    asm volatile("" ::: "memory");
#pragma unroll
    for (int j = 0; j < 8; ++j) { const f32x4 g = *(const f32x4*)(g2 + 4 * lane + 256 * j), bb = *(const f32x4*)(b2 + 4 * lane + 256 * j);
        v[j] = (v[j] - mean) * rstd * g + bb; st_wt16(a.out() + (size_t)row * DM + 4 * lane + 256 * j, __builtin_bit_cast(u32x4, v[j])); }
    asm volatile("" ::: "memory");
    if (l + 1 < NLAYER) {
        const float* ada2 = (const float*)(ws + WS_ADA) + (size_t)((l + 1) * 2 + b) * ADA_W;
        row_stats(v, mean, rstd);
        bf16* hrow = (bf16*)(ws + WS_H) + (size_t)row * DM;
#pragma unroll
        for (int j = 0; j < 8; ++j) { const f32x4 s1 = *(const f32x4*)(ada2 + DM + 4 * lane + 256 * j) + 1.0f, s0 = *(const f32x4*)(ada2 + 4 * lane + 256 * j);
            const f32x4 y = (v[j] - mean) * rstd * s1 + s0;
            u32x2 w; w.x = cvt_pk_bf16(y.x, y.y); w.y = cvt_pk_bf16(y.z, y.w); st_wt8(hrow + 4 * lane + 256 * j, w); }
    }
}

__device__ __forceinline__ Frame make_frame(unsigned char* ws) {
    extern __shared__ __attribute__((aligned(16))) unsigned char lds_raw[];
    Frame F;
    F.lds = (LAS unsigned char*)lds_raw;
    F.MISC = (volatile LAS unsigned*)(F.lds + MISC_OFF);
    int t = tid_x(); asm volatile("" : "+v"(t));
    F.tid = t; F.lane = t & 63; F.wave = __builtin_amdgcn_readfirstlane(t >> 6);
    F.G = gridDim.x; F.gw = blockIdx.x * 8 + F.wave; F.NGW = F.G * 8;
    F.ctl = (unsigned*)(ws + WS_CTL);
    return F;
}

__global__ void __launch_bounds__(512, 2) mk_fwd(Args args) {
    extern __shared__ __attribute__((aligned(16))) unsigned char lds_raw[];
    XcdBarrier bar;
    int lo, hi;
    {
        const KA a = fresh_ka(); unsigned char* ws = a.ws();
        LAS unsigned char* lds = (LAS unsigned char*)lds_raw;
        for (int u = threadIdx.x; u < 128; u += 512) ((LAS unsigned*)(lds + MISC_OFF))[u] = 0u;
        __syncthreads();
        if ((threadIdx.x & 63) == 0) ((LAS int*)(lds + MISC_OFF))[64 + hw_wave_slot()] = (int)(threadIdx.x >> 6);
        __syncthreads();
        unsigned* ctl = (unsigned*)(ws + WS_CTL);
        bar.bar = ctl + CW_BAR; bar.x = 0; bar.st = (volatile LAS unsigned*)(lds + MISC_OFF) + 8;
        if (!MK_PER_PHASE) bar = xcd_barrier_post(ctl + CW_BAR, (volatile LAS unsigned*)(lds + MISC_OFF) + 8);
        lo = a.ph_lo(); hi = a.ph_hi();
    }
#ifndef PHMASK
#define PHMASK 0xFFFFu
#endif
#define PT(t) (((PHMASK) >> (t)) & 1u)
#define IN(k) (lo <= (k) && (k) < hi)
#define SEAM(k) do { if (!MK_PER_PHASE && (k) + 1 < hi) xcd_barrier_work(bar, a, ws, F.lds); } while (0)
#define PHASE_BEGIN() const KA a = fresh_ka(); unsigned char* ws = a.ws(); Frame F = make_frame(ws); (void)F

    if (PT(0) && IN(0)) { PHASE_BEGIN(); p0_prologue(F, a); SEAM(0); }
    if (PT(1) && IN(1)) {
        PHASE_BEGIN();
        const float* ADA = (const float*)(ws + WS_ADA); bf16* H = (bf16*)(ws + WS_H); const float* x = a.in(0);
        for (int row = F.gw; row < NTOK; row += F.NGW) { const float* ada = ADA + (size_t)(row >> 12) * ADA_W;
            ln_mod_row(x + (size_t)row * DM, ada, ada + DM, H + (size_t)row * DM, F.lane); }
        SEAM(1);
    }
#pragma unroll 1
    for (int l = 0; l < NLAYER; ++l) {
        const int pb = 2 + 8 * l;
        if (PT(2) && IN(pb + 0)) {
            PHASE_BEGIN(); unsigned char* wl = ws + WS_W + (size_t)l * W_LSTRIDE;
            pg8::DenseSched S; S.init(ws + WS_H, DM, wl + W_IN, NTOK, UW, DM, F.G, (int)blockIdx.x);
            pg8::EpiBf16 E{(bf16*)(ws + WS_U), UW};
            pg8::gemm_phase<GEMM_SP2, true>(F.lds, S, E, DM);
            SEAM(pb + 0);
        }
        if (PT(3) && IN(pb + 1)) {
            PHASE_BEGIN(); bf16* U = (bf16*)(ws + WS_U);
            const float* gq = a.in(5) + (size_t)l * 512; const float* gkv = a.in(7) + (size_t)l * 256;
            for (int row = F.gw; row < NTOK; row += F.NGW)
                post_u_row(U + (size_t)row * UW, row & (SEQ - 1), gq, gkv, (const f32x2*)(ws + WS_ROPEM), (const f32x2*)(ws + WS_ROPED), F.lane);
            SEAM(pb + 1);
        }
        if (PT(4) && IN(pb + 2)) {
            PHASE_BEGIN(); unsigned char* wl = ws + WS_W + (size_t)l * W_LSTRIDE; bf16* U = (bf16*)(ws + WS_U);
            const bool has_na = (((int)blockIdx.x >> 3) & 1) == 0 || F.G != 256;
            { pg8::DenseSched S;
              if (F.G == 256) S.init(U + U_CQ, UW, wl + W_UQ, NTOK, QMW, 512, 128, has_na ? (1 << 20) : (int)((blockIdx.x & 7) + 8 * (blockIdx.x >> 4)));
              else S.init(U + U_CQ, UW, wl + W_UQ, NTOK, QMW, 512, F.G, (int)blockIdx.x);
              pg8::EpiBf16 E{(bf16*)(ws + WS_QM), QMW}; pg8::gemm_phase<GEMM_SP2, false>(F.lds, S, E, 512); }
            { pg8::DenseSched S; S.init(U + U_CKV, UW, wl + W_UKV, NTOK, KVW, 256, F.G, (int)blockIdx.x);
              pg8::EpiBf16 E{(bf16*)(ws + WS_KVM), KVW}; pg8::gemm_phase<GEMM_SP2, false>(F.lds, S, E, 256); }
            {
                att::AttnP P; P.U = (const bf16*)(ws + WS_U); P.QM = (const bf16*)(ws + WS_QM); P.KVM = (const bf16*)(ws + WS_KVM); P.MIX = (bf16*)(ws + WS_MIX);
                P.O1 = (float*)(ws + WS_O1); P.O2 = (float*)(ws + WS_O2); P.ropeM = (const f32x2*)(ws + WS_ROPEM); P.rpb = a.in(9) + (size_t)l * 4 * 465;
                LAS char* al = (LAS char*)F.lds;
                for (int c = blockIdx.x; c < 256; c += F.G) {
                    const int xcd = c & 7, j = c >> 3;
                    const int du = (xcd * 16 + (j & 15));
                    if (j >> 4) att::attn_unit<att::MODE_DIFF, 1>(P, du, al); else att::attn_unit<att::MODE_DIFF, 0>(P, du, al);
                    if (!(j & 1)) att::attn_unit<att::MODE_NA>(P, xcd * 16 + (j >> 1), al);
                }
            }
            SEAM(pb + 2);
        }
        if (PT(5) && IN(pb + 3)) {
            PHASE_BEGIN();
            att::AttnP P; P.U = (const bf16*)(ws + WS_U); P.QM = (const bf16*)(ws + WS_QM); P.KVM = (const bf16*)(ws + WS_KVM); P.MIX = (bf16*)(ws + WS_MIX);
            P.O1 = (float*)(ws + WS_O1); P.O2 = (float*)(ws + WS_O2); P.ropeM = (const f32x2*)(ws + WS_ROPEM);
            P.rpb = a.in(9) + (size_t)l * 4 * 465;
            LAS char* al = (LAS char*)F.lds;
#ifndef ATT_MASK
#define ATT_MASK 7
#endif
            {
                const float lam_init = (l == 0) ? 0.2f : 0.35550906759096934f;
                const float la = a.in(10)[l * 64 + F.lane] * a.in(11)[l * 64 + F.lane], lb = a.in(12)[l * 64 + F.lane] * a.in(13)[l * 64 + F.lane];
                const float lam = __expf(wave_sum(la)) - __expf(wave_sum(lb)) + lam_init;
                const float* o1 = (const float*)(ws + WS_O1); const float* o2 = (const float*)(ws + WS_O2); bf16* MIXp = (bf16*)(ws + WS_MIX);
                for (int row = F.gw; row < NTOK; row += F.NGW)
                    diff_combine_row(o1 + (size_t)row * 512, o2 + (size_t)row * 512, MIXp + (size_t)row * DM, lam, a.in(14) + l * 128, 1.0f - lam_init, F.lane);
                __syncthreads();
            }
            const bool conv_first = ((blockIdx.x >> 3) & 1) != 0;
            if (conv_first) conv_drain(a, ws, F.lds, (l + 1) * Q_PER_L, CONV_QUOTA);
            for (int c = blockIdx.x; c < 256; c += F.G) {
                const int xcd = c & 7, j = c >> 3;
                if (ATT_MASK & 1) att::attn_unit<att::MODE_MLA>(P, (xcd * 2 + (j >> 4)) * 16 + (j & 15), al);
            }
            if (!conv_first) conv_drain(a, ws, F.lds, (l + 1) * Q_PER_L, CONV_QUOTA);
            SEAM(pb + 3);
        }
        if (PT(6) && IN(pb + 4)) {
            PHASE_BEGIN(); unsigned char* wl = ws + WS_W + (size_t)l * W_LSTRIDE;
            const float* xin = (l == 0) ? a.in(0) : (const float*)a.out();
            pg8::DenseSched S; S.init(ws + WS_MIX, DM, wl + W_O, NTOK, DM, DM, F.G, (int)blockIdx.x);
            pg8::EpiResid E{xin, (const float*)(ws + WS_ADA) + (size_t)(l * 2) * ADA_W + 2 * DM, (float*)(ws + WS_Y)};
            pg8::gemm_phase<GEMM_SP2, false>(F.lds, S, E, DM);
            SEAM(pb + 4);
        }
        if (PT(7) && IN(pb + 5)) {
            PHASE_BEGIN();
            for (int t = blockIdx.x; t < NTOK / 32; t += F.G) p6_tile(F, a, l, t);
            conv_drain(a, ws, F.lds, (l + 1) * Q_PER_L);
            SEAM(pb + 5);
        }
        if (PT(8) && IN(pb + 6)) {
            PHASE_BEGIN(); unsigned char* wl = ws + WS_W + (size_t)l * W_LSTRIDE;
            LAS int* pref = (LAS int*)(F.lds + EXTRA_OFF); LAS int* cntL = pref + 80;
            moe_tables(F, a, l, pref, cntL);
            unsigned* ready = F.ctl + CW_MT + l * 32768;
            const int tgu = pref[NE1] * 4;
            const int moe_c = (MOE_CHUNK && (F.G & 7) == 0) ? (int)((blockIdx.x & 7u) * (unsigned)(F.G >> 3) + (blockIdx.x >> 3)) : (int)blockIdx.x;
            const bool f8 = MOE_FP8_LAST && (MOE_FP8_GU_ALL || l == NLAYER - 1);
            const bool f8d = f8 || (MOE_FP8_LAST && MOE_FP8_DOWN_ALL);
            {
                pg8::MoeGUSched S; S.Hb = (const char*)(ws + WS_H); S.W = (const char*)(wl + W_GU); S.list = (const int*)(ws + WS_LIST); S.pref = pref; S.cnt = cntL;
                S.total = tgu; S.G = F.G; S.c = moe_c; S.rowB = f8 ? DM : DM * 2;
                if (f8) { pg8::EpiGateUpT<true> E{(bf16*)(ws + WS_ACT), ready}; pg8::gemm_phase<GEMM_SP2, true, true>(F.lds, S, E, DM / 2, 121, 127); }
                else if (f8d) { pg8::EpiGateUpT<true> E{(bf16*)(ws + WS_ACT), ready}; pg8::gemm_phase<GEMM_SP2, true>(F.lds, S, E, DM); }
                else { pg8::EpiGateUp E{(bf16*)(ws + WS_ACT), ready}; pg8::gemm_phase<GEMM_SP2, true>(F.lds, S, E, DM); }
            }
            {
                pg8::MoeDownSched S; S.Act = (const char*)(ws + WS_ACT); S.W = (const char*)(wl + W_D); S.pref = pref; S.total = pref[NE1] * 8; S.G = F.G;
                const int n6r = tgu % F.G; S.c = (int)((moe_c + F.G - n6r) % F.G);
                if (DOWN_LEAD > 0 && n6r > 0) { S.n6 = n6r; S.lead = (moe_c >= n6r) ? 1 : 0; }
                else { S.n6 = F.G; S.lead = 0; }
                S.ready = ready; S.tmo = F.ctl + CW_TMO; S.rowB = f8d ? FFE : FFE * 2;
                pg8::EpiFp8 E{ws + WS_YS, DM, YS_SCALE};
                if (f8d) pg8::gemm_phase<GEMM_SP2, true, true>(F.lds, S, E, FFE / 2, 121, 125);
                else pg8::gemm_phase<GEMM_SP2, true>(F.lds, S, E, FFE);
            }
            SEAM(pb + 6);
        }
        if (PT(10) && IN(pb + 7)) {
            PHASE_BEGIN();
            LAS int* pref = (LAS int*)(F.lds + EXTRA_OFF); LAS int* cntL = pref + 80;
            moe_tables(F, a, l, pref, cntL);
            {
                const int* tokslot = (const int*)(ws + WS_TOKSLOT); const float* tokw = (const float*)(ws + WS_TOKW);
                int t = 0; float w = 0.f;
                if (F.lane < 8 && F.gw < NTOK) { t = tokslot[F.gw * 8 + F.lane]; w = tokw[F.gw * 8 + F.lane]; }
#pragma unroll 1
                for (int row = F.gw; row < NTOK; row += F.NGW) { int tn = 0; float wn = 0.f; const int nr = row + F.NGW;
                    if (F.lane < 8 && nr < NTOK) { tn = tokslot[nr * 8 + F.lane]; wn = tokw[nr * 8 + F.lane]; }
                    p9_row(a, l, row, pref, F.lane, t, w); t = tn; w = wn; }
            }
            SEAM(pb + 7);
        }
    }
#undef IN
#undef SEAM
}

extern "C" void kernel_launch(void* const* d_in, const int* in_sizes, int n_in, void* d_out, int out_size, void* d_ws, size_t ws_size, hipStream_t stream) {
    static int grid = 0;
    if (grid == 0) {
        if (n_in != 28 || out_size != NTOK * DM || ws_size < WS_END) { fprintf(stderr, "kernel_launch: unexpected shapes: n_in %d out %d ws %zu (need %zu)\n", n_in, out_size, ws_size, (size_t)WS_END); grid = -1; return; }
        int dev = 0, cus = 0, per_cu = 0;
        if (hipGetDevice(&dev) != hipSuccess || hipDeviceGetAttribute(&cus, hipDeviceAttributeMultiprocessorCount, dev) != hipSuccess) { grid = -1; return; }
        if (hipFuncSetAttribute((const void*)mk_fwd, hipFuncAttributeMaxDynamicSharedMemorySize, LDS_BYTES) != hipSuccess) { fprintf(stderr, "kernel_launch: hipFuncSetAttribute failed\n"); grid = -1; return; }
        if (hipOccupancyMaxActiveBlocksPerMultiprocessor(&per_cu, (const void*)mk_fwd, 512, LDS_BYTES) != hipSuccess || per_cu < 1) { fprintf(stderr, "kernel_launch: occupancy query says %d\n", per_cu); }
        (void)hipGetLastError();
        grid = cus;
    }
    if (grid < 0) return;
    (void)hipMemsetAsync((char*)d_ws + WS_CTL, 0, CTL_ZERO_BYTES, stream);
    Args a{};
    for (int i = 0; i < 28; ++i) a.in[i] = (const float*)d_in[i];
    a.out = (float*)d_out; a.ws = (unsigned char*)d_ws;
#if MK_PER_PHASE
    for (int p = 0; p < NPHASE; ++p) { a.ph_lo = p; a.ph_hi = p + 1; hipLaunchKernelGGL(mk_fwd, dim3(grid), dim3(512), LDS_BYTES, stream, a); }
#else
    a.ph_lo = 0; a.ph_hi = NPHASE;
    hipLaunchKernelGGL(mk_fwd, dim3(grid), dim3(512), LDS_BYTES, stream, a);
#endif
    const hipError_t le = hipPeekAtLastError();
    if (le != hipSuccess) fprintf(stderr, "kernel_launch: launch failed: %s\n", hipGetErrorName(le));
}
```

```cpp
#include <hip/hip_runtime.h>
#include <cstdio>
#include <cstdint>

#ifndef MK_PER_PHASE
#define MK_PER_PHASE 0
#endif

#define LAS __attribute__((address_space(3)))
#define GAS __attribute__((address_space(1)))
typedef unsigned short bf16;
typedef short bf16x8 __attribute__((ext_vector_type(8)));
typedef short s16x4 __attribute__((ext_vector_type(4)));
typedef float f32x2 __attribute__((ext_vector_type(2)));
typedef float f32x4 __attribute__((ext_vector_type(4)));
typedef float f32x16 __attribute__((ext_vector_type(16)));
typedef unsigned u32x2 __attribute__((ext_vector_type(2)));
typedef unsigned u32x4 __attribute__((ext_vector_type(4)));

constexpr int NTOK = 8192, SEQ = 4096, DM = 2048, NLAYER = 2;
constexpr int UW = 4096;
constexpr int U_CQ = 0, U_CKV = 512, U_KR = 768, U_NA = 1024, U_DF = 2560;
constexpr int QMW = 1536, KVW = 2048;
constexpr int NEXP = 64, FFE = 512, NE1 = 65;
constexpr int SLOT_MAX = 90112;
constexpr float DN_ALPHA = 1.4142135623730951f;
constexpr float LN_EPS = 1e-5f, RMS_EPS = 1e-6f;
constexpr int ADA_W = 6 * DM;
constexpr float YS_SCALE = 16.f;
#ifndef MOE_FP8_LAST
#ifndef DOWN_LEAD
#define DOWN_LEAD 4
#endif
#ifndef MOE_CHUNK
#define MOE_CHUNK 1
#endif
#define MOE_FP8_LAST 1
#endif
#ifndef MOE_FP8_GU_ALL
#define MOE_FP8_GU_ALL 1
#endif
#ifndef MOE_FP8_DOWN_ALL
#define MOE_FP8_DOWN_ALL 1
#endif
constexpr float W8_SCALE = 64.f, ACT8_SCALE = 4.f;
__device__ __forceinline__ float clamp8(float x) { return __builtin_amdgcn_fmed3f(x, -448.f, 448.f); }

constexpr size_t MiB = 1u << 20;
constexpr size_t WS_CTL = 0, CTL_ZERO_BYTES = 1 * MiB;
constexpr size_t WS_ADA = 1 * MiB;
constexpr size_t WS_ROPEM = 2 * MiB;
constexpr size_t WS_ROPED = 3 * MiB;
constexpr size_t WS_LIST = 4 * MiB;
constexpr size_t WS_TOKSLOT = 6 * MiB;
constexpr size_t WS_TOKW = 6 * MiB + 512 * 1024;
constexpr size_t WS_H = 8 * MiB;
constexpr size_t WS_U = 40 * MiB;
constexpr size_t WS_QM = 104 * MiB;
constexpr size_t WS_KVM = 128 * MiB;
constexpr size_t WS_MIX = 160 * MiB;
constexpr size_t WS_O1 = 192 * MiB;
constexpr size_t WS_O2 = 784 * MiB;
constexpr size_t WS_Y = 208 * MiB;
constexpr size_t WS_X1 = 272 * MiB;
constexpr size_t WS_ACT = 336 * MiB;
constexpr size_t WS_YS = 432 * MiB;
constexpr size_t WS_W = 800 * MiB, W_LSTRIDE = 424 * MiB;
constexpr size_t W_IN = 0, W_UQ = 16 * MiB, W_UKV = 18 * MiB, W_O = 20 * MiB, W_R = 28 * MiB, W_GU = 32 * MiB, W_D = 292 * MiB;
constexpr size_t WS_END = WS_W + 2 * W_LSTRIDE;
static_assert(WS_ACT + (size_t)SLOT_MAX * 512 * 2 <= WS_YS && WS_YS + (size_t)SLOT_MAX * 2048 * 2 <= WS_O2 && WS_O2 + 16 * MiB <= WS_W, "ws map");
static_assert(W_GU + (size_t)NE1 * 1024 * 2048 * 2 <= W_D && W_D + (size_t)NE1 * 2048 * 512 * 2 <= W_LSTRIDE, "w map");
constexpr int CW_TMO = 0, CW_BAR = 4096, CW_CNT = 16384;
constexpr int CW_MT = 65536;

constexpr int LDS_BYTES = 147456;
constexpr int RING_BYTES = 131072;
constexpr int EXTRA_OFF = 131072;
constexpr int MISC_OFF = LDS_BYTES - 512;

#define RLX_AGENT __ATOMIC_RELAXED, __HIP_MEMORY_SCOPE_AGENT
#define LDS_WAIT() asm volatile("s_waitcnt lgkmcnt(0)" ::: "memory")
#define VM_WAIT() asm volatile("s_waitcnt vmcnt(0)" ::: "memory")

__device__ __forceinline__ unsigned cvt_pk_bf16(float lo, float hi) { unsigned r; asm volatile("v_cvt_pk_bf16_f32 %0, %1, %2" : "=v"(r) : "v"(lo), "v"(hi)); return r; }
__device__ __forceinline__ float bf2f(unsigned short b) { return __builtin_bit_cast(float, (unsigned)b << 16); }
__device__ __forceinline__ float bflo(unsigned w) { return __builtin_bit_cast(float, w << 16); }
__device__ __forceinline__ float bfhi(unsigned w) { return __builtin_bit_cast(float, w & 0xffff0000u); }
__device__ __forceinline__ float ldg_f32(const void* b, unsigned off) { return *(const float*)((const char*)b + off); }
__device__ __forceinline__ void stg_f32(void* b, unsigned off, float v) { *(float*)((char*)b + off) = v; }
__device__ __forceinline__ void stg_u16(void* b, unsigned off, unsigned short v) { *(unsigned short*)((char*)b + off) = v; }
__device__ __forceinline__ bf16x8 ldg_b128(const void* b, unsigned off) { return *(const bf16x8*)((const char*)b + off); }
__device__ __forceinline__ int hw_wave_slot() { return (int)(__builtin_amdgcn_s_getreg((5 << 11) | 4) & 63u); }
__device__ __forceinline__ int tid_x() {
    extern __shared__ __attribute__((aligned(16))) unsigned char lds_raw_t[];
    const int w = ((volatile LAS int*)((LAS unsigned char*)lds_raw_t + MISC_OFF))[64 + hw_wave_slot()];
    int l; asm volatile("v_mbcnt_lo_u32_b32 %0, -1, 0\n\tv_mbcnt_hi_u32_b32 %0, -1, %0" : "=v"(l));
    return __builtin_amdgcn_readfirstlane(w) * 64 + l;
}
__device__ __forceinline__ int lane_id_local() { int l; asm volatile("v_mbcnt_lo_u32_b32 %0, -1, 0\n\tv_mbcnt_hi_u32_b32 %0, -1, %0" : "=v"(l)); return l; }
__device__ __forceinline__ float shfl_idx(float v, int src) { return __builtin_bit_cast(float, __builtin_amdgcn_ds_bpermute(src << 2, __builtin_bit_cast(int, v))); }
#ifndef WSUM_DPP
#define WSUM_DPP 1
#endif
__device__ __forceinline__ float wave_sum(float v) {
#if WSUM_DPP
#define WS_STEP(ctrl, rmask) v += __builtin_bit_cast(float, __builtin_amdgcn_update_dpp(0, __builtin_bit_cast(int, v), ctrl, rmask, 0xf, false))
    WS_STEP(0x111, 0xf); WS_STEP(0x112, 0xf); WS_STEP(0x114, 0xf); WS_STEP(0x118, 0xf);
    WS_STEP(0x142, 0xa); WS_STEP(0x143, 0xc);
#undef WS_STEP
    return __builtin_bit_cast(float, __builtin_amdgcn_readlane(__builtin_bit_cast(int, v), 63));
#else
    const int l = lane_id_local();
#pragma unroll
    for (int o = 1; o < 64; o <<= 1) v += shfl_idx(v, l ^ o);
    return v;
#endif
}

#define XB_TMO      128
#define XB_XCNT(j)  (256  + 64 * (j))
#define XB_XSUB(j)  (1280 + 64 * (j))
#define XB_XGEN(j)  (2304 + 64 * (j))
#define XB_TOP      3328
#define XB_TOPGEN   3392
#define XCD_BAR_WORDS 3456
#define XB_SPIN_CAP (1u << 22)

__device__ __forceinline__ unsigned xb_ld(unsigned* p)              { return __hip_atomic_load(p, __ATOMIC_RELAXED, __HIP_MEMORY_SCOPE_AGENT); }
__device__ __forceinline__ unsigned xb_add(unsigned* p, unsigned v) { return __hip_atomic_fetch_add(p, v, __ATOMIC_RELAXED, __HIP_MEMORY_SCOPE_AGENT); }
__device__ __forceinline__ unsigned xb_xcc_id() { return (unsigned)__builtin_amdgcn_s_getreg((3 << 11) | 20) & 0xFu; }
#define XB_SPIN(cond, bar) do { unsigned _sp = 0; while (cond) { __builtin_amdgcn_s_sleep(1); \
    if ((++_sp & 255u) == 0u) { if (xb_ld(&(bar)[XB_TMO])) break; if (_sp > XB_SPIN_CAP) { atomicAdd(&(bar)[XB_TMO], 1u); break; } } } } while (0)

struct XcdBarrier { unsigned* bar; unsigned x; volatile LAS unsigned* st; };

__device__ __forceinline__ XcdBarrier xcd_barrier_post(unsigned* bar, volatile LAS unsigned* st) {
    XcdBarrier b; b.bar = bar; b.x = xb_xcc_id(); b.st = st;
    if (tid_x() == 0) (void)xb_add(&bar[XB_XCNT(b.x)], 1u);
    return b;
}
__device__ __forceinline__ void xcd_barrier_complete(unsigned* bar, unsigned x, unsigned& nloc, unsigned& nx) {
    const unsigned G = gridDim.x * gridDim.y * gridDim.z;
    unsigned sum, cnt, mine, sp = 0u;
    for (;;) {
        sum = 0u; cnt = 0u; mine = 0u;
#pragma unroll
        for (unsigned j = 0; j < 16; ++j) { const unsigned c = xb_ld(&bar[XB_XCNT(j)]); sum += c; cnt += (c > 0u) ? 1u : 0u; }
        if (sum == G) break;
        __builtin_amdgcn_s_sleep(1);
        if ((++sp & 255u) == 0u) { if (xb_ld(&bar[XB_TMO])) break; if (sp > XB_SPIN_CAP) { atomicAdd(&bar[XB_TMO], 1u); break; } }
    }
    mine = xb_ld(&bar[XB_XCNT(x)]);
    nloc = mine > 0u ? mine : 1u; nx = cnt > 0u ? cnt : 1u;
}
__device__ __forceinline__ void xcd_barrier(const XcdBarrier& b) {
    asm volatile("s_waitcnt vmcnt(0)" ::: "memory");
    __syncthreads();
    if (tid_x() == 0) {
        unsigned* bar = b.bar;
        __builtin_amdgcn_s_waitcnt(0);
        unsigned nloc = b.st[0], nx = b.st[1];
        if (nloc == 0u) { xcd_barrier_complete(bar, b.x, nloc, nx); b.st[0] = nloc; b.st[1] = nx; }
        const unsigned old = xb_add(&bar[XB_XSUB(b.x)], 1u);
        const unsigned gen = old / nloc;
        if (old + 1u == (gen + 1u) * nloc) {
            __builtin_amdgcn_fence(__ATOMIC_RELEASE, "agent");
            asm volatile("s_waitcnt vmcnt(0)" ::: "memory");
            const unsigned og = xb_add(&bar[XB_TOP], 1u);
            const unsigned tg = og / nx;
            if (og + 1u == (tg + 1u) * nx) xb_add(&bar[XB_TOPGEN], 1u);
            else XB_SPIN(xb_ld(&bar[XB_TOPGEN]) == tg, bar);
            __builtin_amdgcn_fence(__ATOMIC_ACQUIRE, "agent");
            xb_add(&bar[XB_XGEN(b.x)], 1u);
            asm volatile("s_waitcnt vmcnt(0)" ::: "memory");
        } else {
            XB_SPIN(xb_ld(&bar[XB_XGEN(b.x)]) == gen, bar);
            __builtin_amdgcn_fence(__ATOMIC_ACQUIRE, "agent");
            asm volatile("s_waitcnt vmcnt(0)" ::: "memory");
        }
    }
    __syncthreads();
}

namespace pg8 {
constexpr int BM = 256, BK = 64, HALF = 128, HTB = HALF * BK * 2, STAGE_BYTES = 8 * HTB;
__host__ __device__ __forceinline__ int lds_byte(int r, int c) { const int st = (r >> 4) * 2 + (c >> 5), rr = r & 15, cc = c & 31, ob = rr * 64 + cc * 2; return st * 1024 + (ob ^ (((ob >> 9) & 1) << 5)); }
__host__ __device__ __forceinline__ void stage_rc(int b, int& R, int& C) { const int st = b / 1024, sb = b % 1024, swz = sb ^ (((sb >> 9) & 1) << 5); R = (st >> 1) * 16 + swz / 64; C = (st & 1) * 32 + (swz % 64) / 2; }
__host__ __device__ __forceinline__ int perm32(int rho) { const int n = rho >> 4, i = rho & 15; return 8 * (i >> 2) + 4 * n + (i & 3); }

typedef int v8i32 __attribute__((ext_vector_type(8)));
struct Frag2 { bf16x8 lo, hi; };
template <bool SP2, bool ALIGN_EPI, bool FP8 = false, class Epi, class Sched>
__device__ __forceinline__ void gemm_phase(LAS unsigned char* lds, const Sched& S, const Epi& E, const int K, const int s1 = 127, const int s2 = 127) {
    int tid = tid_x(); asm volatile("" : "+v"(tid));
    int s1v = s1, s2v = s2; asm volatile("" : "+v"(s1v), "+v"(s2v));
    const int wid = __builtin_amdgcn_readfirstlane(tid >> 6), lane = tid & 63, wr = wid >> 2, wc = wid & 3, fr = lane & 15, fq = lane >> 4;
    const int nt = K / BK;
    unsigned voffB[2];
#pragma unroll
    for (int i = 0; i < 2; ++i) { int R, C; stage_rc(tid * 16 + i * 8192, R, C);
        int Rb = R;
        if constexpr (Epi::PERM == 1) Rb = (R & ~31) + perm32(R & 31);
        if constexpr (Epi::PERM == 2) Rb = 64 * (R >> 5) + 16 * ((R >> 2) & 3) + 4 * ((R >> 4) & 1) + (R & 3);
        voffB[i] = (unsigned)(Rb * K + C) * 2u; }
    const size_t kstep = (size_t)(BK * 2);
    const size_t hstepB = (size_t)(Epi::PERM == 2 ? 8 : HALF) * K * 2;
    const unsigned ldsw = (unsigned)wid * 1024u;
    const int aoff = lds_byte(wr * 64 + fr, fq * 8), boff = lds_byte(wc * 32 + fr, fq * 8);
#define PG8_SA(b, h) (((b) * 2 + (h)) * HTB)
#define PG8_SB(b, h) ((4 + (b) * 2 + (h)) * HTB)
#define PG8_STAGE_B(bufoff, gbase) do { _Pragma("unroll") for (int _i = 0; _i < 2; ++_i) \
        __builtin_amdgcn_global_load_lds((const unsigned*)((const char*)(gbase) + voffB[_i]), (LAS unsigned*)(lds + (bufoff) + ldsw + _i * 8192), 16, 0, 0); } while (0)
#define PG8_STAGE_A(bufoff, kbyte, OFF, h) do { _Pragma("unroll") for (int _i = 0; _i < 2; ++_i) \
        __builtin_amdgcn_global_load_lds((const unsigned*)(Ab + (kbyte) + OFF[(h) * 2 + _i]), (LAS unsigned*)(lds + (bufoff) + ldsw + _i * 8192), 16, 0, 0); } while (0)
#define PG8_LDA(dst, b, h) do { _Pragma("unroll") for (int m = 0; m < 4; ++m) _Pragma("unroll") for (int k = 0; k < 2; ++k) dst[m][k] = *(const LAS bf16x8*)(lds + PG8_SA(b, h) + aoff + m * 2048 + k * 1024); } while (0)
#define PG8_LDB(dst, b, h) do { _Pragma("unroll") for (int n = 0; n < 2; ++n) _Pragma("unroll") for (int k = 0; k < 2; ++k) dst[n][k] = *(const LAS bf16x8*)(lds + PG8_SB(b, h) + boff + n * 2048 + k * 1024); } while (0)
#define PG8_MMA(ai, bj, At, Bt) do { __builtin_amdgcn_s_setprio(1); if constexpr (FP8) { _Pragma("unroll") for (int m = 0; m < 4; ++m) _Pragma("unroll") for (int n = 0; n < 2; ++n) \
        acc[ai][bj][m][n] = __builtin_amdgcn_mfma_scale_f32_16x16x128_f8f6f4(__builtin_bit_cast(v8i32, (Frag2){Bt[n][0], Bt[n][1]}), __builtin_bit_cast(v8i32, (Frag2){At[m][0], At[m][1]}), acc[ai][bj][m][n], 0, 0, 0, s1v, 0, s2v); } else { \
        _Pragma("unroll") for (int m = 0; m < 4; ++m) _Pragma("unroll") for (int n = 0; n < 2; ++n) _Pragma("unroll") for (int k = 0; k < 2; ++k) \
        acc[ai][bj][m][n] = __builtin_amdgcn_mfma_f32_16x16x32_bf16(Bt[n][k], At[m][k], acc[ai][bj][m][n], 0, 0, 0); } __builtin_amdgcn_s_setprio(0); } while (0)
#define PG8_WAIT_V(n) asm volatile("s_waitcnt vmcnt(" #n ")" ::: "memory")
#define PG8_WAIT_L(n) asm volatile("s_waitcnt lgkmcnt(" #n ")" ::: "memory")
#define PG8_BAR __builtin_amdgcn_s_barrier()
#define PG8_SCHED __builtin_amdgcn_sched_barrier(0)
    typename Sched::Unit cur, nxt; int ui = 0;
    if (!S.next(0, cur)) return;
    f32x4 acc[2][2][4][2];
#pragma unroll
    for (int a = 0; a < 2; ++a)
#pragma unroll
        for (int b = 0; b < 2; ++b)
#pragma unroll
            for (int m = 0; m < 4; ++m)
#pragma unroll
                for (int n = 0; n < 2; ++n) acc[a][b][m][n] = (f32x4){0.f, 0.f, 0.f, 0.f};
    bf16x8 At[4][2], B0[2][2], B1[2][2];
    unsigned ao[4], no[4];
    const char* const Ab = S.abase();
    unsigned peek = 0u;
    if constexpr (Sched::HAS_READY) S.a_ready(cur, wid, 0u);
    S.aoffs(cur, tid, ao);
    if constexpr (Sched::PREFETCH) {
#pragma unroll
        for (int j = 0; j < 4; ++j) no[j] = ao[j];
    }
    const char* cB = S.bptr(cur);
    if constexpr (SP2) {
        PG8_STAGE_B(PG8_SB(0, 0), cB); PG8_STAGE_B(PG8_SB(0, 1), cB + hstepB); PG8_STAGE_A(PG8_SA(0, 0), 0, ao, 0); PG8_STAGE_A(PG8_SA(0, 1), 0, ao, 1);
        if (wr == 1) PG8_BAR;
        PG8_WAIT_V(2); PG8_BAR;
        PG8_STAGE_B(PG8_SB(1, 0), cB + kstep); PG8_STAGE_A(PG8_SA(1, 0), kstep, ao, 0); PG8_STAGE_B(PG8_SB(1, 1), cB + hstepB + kstep);
        PG8_WAIT_V(6); PG8_BAR;
    } else {
        PG8_STAGE_B(PG8_SB(0, 0), cB); PG8_STAGE_A(PG8_SA(0, 0), 0, ao, 0); PG8_STAGE_B(PG8_SB(0, 1), cB + hstepB); PG8_STAGE_A(PG8_SA(0, 1), 0, ao, 1);
        if (wr == 1) PG8_BAR;
        PG8_WAIT_V(4); PG8_BAR;
        PG8_STAGE_B(PG8_SB(1, 0), cB + kstep); PG8_STAGE_A(PG8_SA(1, 0), kstep, ao, 0); PG8_STAGE_B(PG8_SB(1, 1), cB + hstepB + kstep);
        PG8_WAIT_V(6); PG8_BAR;
    }
    for (;;) {
        const bool has_next = S.next(ui + 1, nxt);
        if constexpr (Sched::PREFETCH) { if (has_next) S.aoffs(nxt, tid, no); }
        if constexpr (Sched::HAS_READY) { if (has_next) peek = S.a_peek(nxt); }
        const char* nB = has_next ? S.bptr(nxt) : cB;
#pragma unroll 1
        for (int t = 0; t < nt; t += 2) {
            const bool last = (t == nt - 2);
            if constexpr (Sched::HAS_READY) { if (last && has_next) S.a_ready(nxt, wid, peek); }
            const size_t ka1 = (size_t)(t + 1) * kstep;
            const size_t k2 = last ? 0 : (size_t)(t + 2) * kstep, k3 = k2 + kstep;
            const char* b2 = last ? nB : cB + (size_t)(t + 2) * kstep; const char* b3 = b2 + kstep;
            if constexpr (SP2) {
            PG8_LDB(B0, 0, 0); PG8_LDB(B1, 0, 1); PG8_SCHED; PG8_LDA(At, 0, 0); PG8_STAGE_A(PG8_SA(1, 1), ka1, ao, 1);
            if (last && has_next) {
                if constexpr (Sched::PREFETCH) {
#pragma unroll
                    for (int j = 0; j < 4; ++j) ao[j] = no[j];
                } else S.aoffs(nxt, tid, ao);
            }
            PG8_WAIT_V(8); PG8_WAIT_L(0); PG8_BAR; PG8_MMA(0, 0, At, B0); PG8_MMA(0, 1, At, B1); PG8_BAR; PG8_SCHED;
            PG8_LDA(At, 0, 1); PG8_STAGE_B(PG8_SB(0, 0), b2); PG8_STAGE_B(PG8_SB(0, 1), b2 + hstepB); PG8_STAGE_A(PG8_SA(0, 0), k2, ao, 0);
            PG8_WAIT_V(8); PG8_WAIT_L(0); PG8_BAR; PG8_MMA(1, 0, At, B0); PG8_MMA(1, 1, At, B1); PG8_BAR; PG8_SCHED;
            PG8_LDB(B0, 1, 0); PG8_LDB(B1, 1, 1); PG8_SCHED; PG8_LDA(At, 1, 0); PG8_STAGE_A(PG8_SA(0, 1), k2, ao, 1);
            PG8_WAIT_V(8); PG8_WAIT_L(0); PG8_BAR; PG8_MMA(0, 0, At, B0); PG8_MMA(0, 1, At, B1); PG8_BAR; PG8_SCHED;
            PG8_LDA(At, 1, 1); PG8_STAGE_B(PG8_SB(1, 0), b3); PG8_STAGE_B(PG8_SB(1, 1), b3 + hstepB); PG8_STAGE_A(PG8_SA(1, 0), k3, ao, 0);
            PG8_WAIT_V(8); PG8_WAIT_L(0); PG8_BAR; PG8_MMA(1, 0, At, B0); PG8_MMA(1, 1, At, B1); PG8_BAR; PG8_SCHED;
            } else {
            PG8_LDB(B0, 0, 0); PG8_SCHED; PG8_LDA(At, 0, 0); PG8_STAGE_A(PG8_SA(1, 1), ka1, ao, 1);
            if (last && has_next) {
                if constexpr (Sched::PREFETCH) {
#pragma unroll
                    for (int j = 0; j < 4; ++j) ao[j] = no[j];
                } else S.aoffs(nxt, tid, ao);
            }
            PG8_WAIT_L(8); PG8_BAR; PG8_WAIT_L(0); PG8_MMA(0, 0, At, B0); PG8_BAR; PG8_SCHED;
            PG8_LDB(B1, 0, 1); PG8_STAGE_B(PG8_SB(0, 0), b2);
            PG8_BAR; PG8_WAIT_L(0); PG8_MMA(0, 1, At, B1); PG8_BAR;
            PG8_LDA(At, 0, 1); PG8_STAGE_A(PG8_SA(0, 0), k2, ao, 0);
            PG8_BAR; PG8_WAIT_L(0); PG8_MMA(1, 0, At, B0); PG8_BAR; PG8_SCHED;
            PG8_STAGE_B(PG8_SB(0, 1), b2 + hstepB);
            PG8_WAIT_V(6); PG8_BAR; PG8_MMA(1, 1, At, B1); PG8_BAR;
            PG8_LDB(B0, 1, 0); PG8_SCHED; PG8_LDA(At, 1, 0); PG8_STAGE_A(PG8_SA(0, 1), k2, ao, 1);
            PG8_WAIT_L(8); PG8_BAR; PG8_WAIT_L(0); PG8_MMA(0, 0, At, B0); PG8_BAR; PG8_SCHED;
            PG8_LDB(B1, 1, 1); PG8_STAGE_B(PG8_SB(1, 0), b3);
            PG8_BAR; PG8_WAIT_L(0); PG8_MMA(0, 1, At, B1); PG8_BAR;
            PG8_LDA(At, 1, 1); PG8_STAGE_A(PG8_SA(1, 0), k3, ao, 0);
            PG8_BAR; PG8_WAIT_L(0); PG8_MMA(1, 0, At, B0); PG8_BAR; PG8_SCHED;
            PG8_STAGE_B(PG8_SB(1, 1), b3 + hstepB);
            PG8_WAIT_V(6); PG8_BAR; PG8_MMA(1, 1, At, B1); PG8_BAR;
                    }
        }
        if constexpr (ALIGN_EPI) { if (wr == 0) PG8_BAR; }
        E(acc, cur, wr, wc, fr, fq);
        if (!has_next) break;
#pragma unroll
        for (int a = 0; a < 2; ++a)
#pragma unroll
            for (int b = 0; b < 2; ++b)
#pragma unroll
                for (int m = 0; m < 4; ++m)
#pragma unroll
                    for (int n = 0; n < 2; ++n) acc[a][b][m][n] = (f32x4){0.f, 0.f, 0.f, 0.f};
        cur = nxt; cB = nB; ++ui;
        if constexpr (ALIGN_EPI) { if (wr == 1) PG8_BAR; }
    }
    PG8_WAIT_V(0);
    if constexpr (Epi::HAS_FINISH) E.finish(fr, fq);
    if constexpr (!ALIGN_EPI) { if (wr == 0) PG8_BAR; }
    PG8_BAR;
#undef PG8_SA
#undef PG8_SB
#undef PG8_STAGE_A
#undef PG8_STAGE_B
#undef PG8_LDA
#undef PG8_LDB
#undef PG8_MMA
#undef PG8_WAIT_V
#undef PG8_WAIT_L
#undef PG8_BAR
#undef PG8_SCHED
}

struct DUnit { int pm, pn, orow0, ocol0; };
struct DenseSched {
    const char* A; unsigned ldaB; const char* Bt; int K; int nM, nN, nwg, G, c;
    typedef DUnit Unit;
    __device__ __forceinline__ void init(const void* A_, int lda_elems, const void* Bt_, int M, int N, int K_, int G_, int c_) {
        A = (const char*)A_; ldaB = (unsigned)lda_elems * 2u; Bt = (const char*)Bt_; K = K_; nM = M / 256; nN = N / 256; nwg = nM * nN; G = G_; c = c_; }
    __device__ __forceinline__ bool next(int i, Unit& u) const {
        const int L = i * G + c; if (L >= nwg) return false;
        int wgid = L; { const int q = nwg / 8, r = nwg % 8, xcd = wgid % 8, off = wgid / 8; wgid = (xcd < r ? xcd * (q + 1) : r * (q + 1) + (xcd - r) * q) + off; }
        const int nig = 8 * nN, gid = wgid / nig, fm = gid * 8, gsz = (nM - fm) < 8 ? (nM - fm) : 8;
        u.pm = fm + ((wgid % nig) % gsz); u.pn = (wgid % nig) / gsz; u.orow0 = u.pm * 256; u.ocol0 = u.pn * 256; return true;
    }
    __device__ __forceinline__ const char* abase() const { return A; }
    static constexpr bool PREFETCH = false, HAS_READY = false;
    __device__ __forceinline__ void aoffs(const Unit& u, int tid, unsigned (&o)[4]) const {
#pragma unroll
        for (int i = 0; i < 2; ++i) { int R, C; stage_rc(tid * 16 + i * 8192, R, C);
#pragma unroll
            for (int h = 0; h < 2; ++h) o[h * 2 + i] = (unsigned)(u.pm * 256 + h * 128 + R) * ldaB + (unsigned)(C * 2); }
    }
    __device__ __forceinline__ const char* bptr(const Unit& u) const { return Bt + (size_t)u.pn * 256 * K * 2; }
};

struct MUnit { int e, mt, pn, orow0, ocol0; };
struct MoeGUSched {
    const char* Hb; const char* W; const int* list; const LAS int* pref; const LAS int* cnt; int total, G, c;
    unsigned rowB;
    typedef MUnit Unit;
    __device__ __forceinline__ bool next(int i, Unit& u) const {
        const int L = i * G + c; if (L >= total) return false;
        const int mtg = L >> 2; u.pn = L & 3;
        int e = pref[400 + mtg];
        e = __builtin_amdgcn_readfirstlane(e);
        u.e = e; u.mt = mtg - pref[e]; u.orow0 = mtg * 256; u.ocol0 = u.pn * 128; return true;
    }
    __device__ __forceinline__ const char* abase() const { return Hb; }
    static constexpr bool PREFETCH = true, HAS_READY = false;
    __device__ __forceinline__ void aoffs(const Unit& u, int tid, unsigned (&o)[4]) const {
        const int n = cnt[u.e];
#pragma unroll
        for (int i = 0; i < 2; ++i) { int R, C; stage_rc(tid * 16 + i * 8192, R, C);
#pragma unroll
            for (int h = 0; h < 2; ++h) { const int pos = u.mt * 256 + h * 128 + R;
                int tok = pos; if (u.e < 64) tok = (pos < n) ? list[u.e * 8192 + pos] : 0;
                o[h * 2 + i] = (unsigned)tok * rowB + (unsigned)(C * 2); } }
    }
    __device__ __forceinline__ const char* bptr(const Unit& u) const { return W + ((size_t)u.e * 1024 + (size_t)u.pn * 256) * rowB; }
};
struct MoeDownSched {
    const char* Act; const char* W; const LAS int* pref; int total, G, c;
    int n6, lead;
    unsigned* ready;
    unsigned* tmo;
    unsigned rowB;
    typedef MUnit Unit;
    __device__ __forceinline__ unsigned a_peek(const Unit& u) const { return __hip_atomic_load(ready + 64 * (u.orow0 >> 8), __ATOMIC_RELAXED, __HIP_MEMORY_SCOPE_AGENT); }
    __device__ __forceinline__ void a_ready(const Unit& u, int wid, unsigned peeked) const {
        if (wid == 0) {
            unsigned* w = ready + 64 * (u.orow0 >> 8); unsigned sp = 0;
            if ((unsigned)__builtin_amdgcn_readfirstlane(peeked) < 32u)
            while ((unsigned)__builtin_amdgcn_readfirstlane(__hip_atomic_load(w, __ATOMIC_RELAXED, __HIP_MEMORY_SCOPE_AGENT)) < 32u) {
                __builtin_amdgcn_s_sleep(2);
                if ((++sp & 255u) == 0u) { if (__hip_atomic_load(tmo, __ATOMIC_RELAXED, __HIP_MEMORY_SCOPE_AGENT) != 0u) break;
                    if (sp > (1u << 22)) { __hip_atomic_store(tmo, 1u, __ATOMIC_RELAXED, __HIP_MEMORY_SCOPE_AGENT); break; } }
            }
            __builtin_amdgcn_fence(__ATOMIC_ACQUIRE, "agent");
            asm volatile("s_waitcnt vmcnt(0)" ::: "memory");
        }
        __builtin_amdgcn_s_barrier();
    }
    __device__ __forceinline__ bool next(int i, Unit& u) const {
        int L;
        if (lead) L = (i < DOWN_LEAD) ? i * (G - n6) + c : DOWN_LEAD * (G - n6) + (i - DOWN_LEAD) * G + c;
        else L = DOWN_LEAD * (G - n6) + i * G + c;
        if (L >= total) return false;
        const int mtg = L >> 3; u.pn = L & 7;
        int e = pref[400 + mtg];
        e = __builtin_amdgcn_readfirstlane(e);
        u.e = e; u.mt = mtg - pref[e]; u.orow0 = mtg * 256; u.ocol0 = u.pn * 256; return true;
    }
    __device__ __forceinline__ const char* abase() const { return Act; }
    static constexpr bool PREFETCH = false, HAS_READY = true;
    __device__ __forceinline__ void aoffs(const Unit& u, int tid, unsigned (&o)[4]) const {
#pragma unroll
        for (int i = 0; i < 2; ++i) { int R, C; stage_rc(tid * 16 + i * 8192, R, C);
#pragma unroll
            for (int h = 0; h < 2; ++h) o[h * 2 + i] = (unsigned)(u.orow0 + h * 128 + R) * rowB + (unsigned)(C * 2); }
    }
    __device__ __forceinline__ const char* bptr(const Unit& u) const { return W + ((size_t)u.e * 2048 + (size_t)u.pn * 256) * rowB; }
};

template <bool NT = false> struct EpiBf16T {
    static constexpr int PERM = 1; static constexpr bool HAS_FINISH = false;
    bf16* O; int ldc;
    template <class U> __device__ __forceinline__ void operator()(const f32x4 (&acc)[2][2][4][2], const U& u, int wr, int wc, int fr, int fq) const {
        const int row0 = u.orow0 + wr * 64 + fr, col0 = u.ocol0 + wc * 32 + 8 * fq;
#pragma unroll
        for (int ai = 0; ai < 2; ++ai)
#pragma unroll
            for (int m = 0; m < 4; ++m) { bf16* rowp = O + (size_t)(row0 + ai * HALF + m * 16) * ldc + col0;
#pragma unroll
                for (int bj = 0; bj < 2; ++bj) { const f32x4 v0 = acc[ai][bj][m][0], v1 = acc[ai][bj][m][1];
                    u32x4 w; w.x = cvt_pk_bf16(v0[0], v0[1]); w.y = cvt_pk_bf16(v0[2], v0[3]); w.z = cvt_pk_bf16(v1[0], v1[1]); w.w = cvt_pk_bf16(v1[2], v1[3]);
                    if constexpr (NT) __builtin_nontemporal_store(w, (u32x4*)(rowp + bj * HALF)); else *(u32x4*)(rowp + bj * HALF) = w; } }
    }
};
typedef EpiBf16T<false> EpiBf16;
struct EpiFp8 {
    static constexpr int PERM = 2; static constexpr bool HAS_FINISH = false;
    unsigned char* O; int ldc; float scale;
    template <class U> __device__ __forceinline__ void operator()(const f32x4 (&acc)[2][2][4][2], const U& u, int wr, int wc, int fr, int fq) const {
        const int row0 = u.orow0 + wr * 64 + fr, col0 = u.ocol0 + wc * 64 + 16 * fq;
#pragma unroll
        for (int ai = 0; ai < 2; ++ai)
#pragma unroll
            for (int m = 0; m < 4; ++m) { u32x4 w;
#pragma unroll
                for (int bj = 0; bj < 2; ++bj) { const f32x4 v0 = acc[ai][bj][m][0] * scale, v1 = acc[ai][bj][m][1] * scale;
                    int a = __builtin_amdgcn_cvt_pk_fp8_f32(clamp8(v0[0]), clamp8(v0[1]), 0, false); a = __builtin_amdgcn_cvt_pk_fp8_f32(clamp8(v0[2]), clamp8(v0[3]), a, true);
                    int b = __builtin_amdgcn_cvt_pk_fp8_f32(clamp8(v1[0]), clamp8(v1[1]), 0, false); b = __builtin_amdgcn_cvt_pk_fp8_f32(clamp8(v1[2]), clamp8(v1[3]), b, true);
                    if (bj == 0) { w.x = (unsigned)a; w.y = (unsigned)b; } else { w.z = (unsigned)a; w.w = (unsigned)b; } }
                *(u32x4*)(O + (size_t)(row0 + ai * HALF + m * 16) * ldc + col0) = w; }
    }
};
__device__ __forceinline__ float silu_mul(float g, float u) { return g * u * __builtin_amdgcn_rcpf(1.f + __builtin_amdgcn_exp2f(-1.4426950408889634f * g)); }
template <bool F8> struct EpiGateUpT {
    static constexpr int PERM = 1;
    bf16* O; unsigned* ready; mutable int pend = -1;
    static constexpr bool HAS_FINISH = true;
    __device__ __forceinline__ void finish(int fr, int fq) const {
        if (pend >= 0 && fr == 0 && fq == 0) __hip_atomic_fetch_add(ready + 64 * pend, 1u, __ATOMIC_RELAXED, __HIP_MEMORY_SCOPE_AGENT);
        pend = -1; }
    template <class U> __device__ __forceinline__ void operator()(const f32x4 (&acc)[2][2][4][2], const U& u, int wr, int wc, int fr, int fq) const {
        if (pend >= 0 && fr == 0 && fq == 0) __hip_atomic_fetch_add(ready + 64 * pend, 1u, __ATOMIC_RELAXED, __HIP_MEMORY_SCOPE_AGENT);
        pend = u.orow0 >> 8;
        const int row0 = u.orow0 + wr * 64 + fr, col0 = u.ocol0 + wc * 32 + 8 * fq;
        const __amdgpu_buffer_rsrc_t rs = __builtin_amdgcn_make_buffer_rsrc(O, 0, (unsigned)((size_t)SLOT_MAX * FFE * 2), 0x00020000);
#pragma unroll
        for (int ai = 0; ai < 2; ++ai)
#pragma unroll
            for (int m = 0; m < 4; ++m) { const unsigned eo = (unsigned)((row0 + ai * HALF + m * 16) * FFE + col0);
                const f32x4 g0 = acc[ai][0][m][0], g1 = acc[ai][0][m][1], u0 = acc[ai][1][m][0], u1 = acc[ai][1][m][1];
                if constexpr (F8) {
                    int a = __builtin_amdgcn_cvt_pk_fp8_f32(clamp8(silu_mul(g0[0], u0[0]) * ACT8_SCALE), clamp8(silu_mul(g0[1], u0[1]) * ACT8_SCALE), 0, false);
                    a = __builtin_amdgcn_cvt_pk_fp8_f32(clamp8(silu_mul(g0[2], u0[2]) * ACT8_SCALE), clamp8(silu_mul(g0[3], u0[3]) * ACT8_SCALE), a, true);
                    int b = __builtin_amdgcn_cvt_pk_fp8_f32(clamp8(silu_mul(g1[0], u1[0]) * ACT8_SCALE), clamp8(silu_mul(g1[1], u1[1]) * ACT8_SCALE), 0, false);
                    b = __builtin_amdgcn_cvt_pk_fp8_f32(clamp8(silu_mul(g1[2], u1[2]) * ACT8_SCALE), clamp8(silu_mul(g1[3], u1[3]) * ACT8_SCALE), b, true);
                    __builtin_amdgcn_raw_buffer_store_b64((u32x2){(unsigned)a, (unsigned)b}, rs, eo, 0, 16);
                } else {
                u32x4 w; w.x = cvt_pk_bf16(silu_mul(g0[0], u0[0]), silu_mul(g0[1], u0[1])); w.y = cvt_pk_bf16(silu_mul(g0[2], u0[2]), silu_mul(g0[3], u0[3]));
                w.z = cvt_pk_bf16(silu_mul(g1[0], u1[0]), silu_mul(g1[1], u1[1])); w.w = cvt_pk_bf16(silu_mul(g1[2], u1[2]), silu_mul(g1[3], u1[3]));
                __builtin_amdgcn_raw_buffer_store_b128(w, rs, eo * 2u, 0, 16); } }
    }
};
typedef EpiGateUpT<false> EpiGateUp;
struct EpiResid {
    static constexpr int PERM = 0; static constexpr bool HAS_FINISH = false;
    const float* X; const float* gate  ; float* Y;
    template <class U> __device__ __forceinline__ void operator()(const f32x4 (&acc)[2][2][4][2], const U& u, int wr, int wc, int fr, int fq) const {
        const int row0 = u.orow0 + wr * 64 + fr, col0 = u.ocol0 + wc * 32 + 4 * fq; const int b = u.orow0 >> 12;
        f32x4 gv[2][2];
#pragma unroll
        for (int bj = 0; bj < 2; ++bj)
#pragma unroll
            for (int n = 0; n < 2; ++n) gv[bj][n] = *(const f32x4*)(gate + (size_t)b * ADA_W + col0 + bj * HALF + 16 * n) + 1.0f;
#pragma unroll
        for (int ai = 0; ai < 2; ++ai)
#pragma unroll
            for (int m = 0; m < 4; ++m) { const size_t ro = (size_t)(row0 + ai * HALF + m * 16) * DM + col0;
#pragma unroll
                for (int bj = 0; bj < 2; ++bj)
#pragma unroll
                    for (int n = 0; n < 2; ++n) { const f32x4 xv = *(const f32x4*)(X + ro + bj * HALF + 16 * n);
                        *(f32x4*)(Y + ro + bj * HALF + 16 * n) = xv * DN_ALPHA + gv[bj][n] * acc[ai][bj][m][n]; } }
    }
};
}

namespace att {
constexpr int NW = 8;
enum { MODE_MLA = 0, MODE_NA = 1, MODE_DIFF = 2 };
constexpr float LOG2E = 1.4426950408889634f;
constexpr float THR = 8.f;
constexpr int SHM_V = 16384, SHM_K = 24576;
constexpr int LDS_VBUF = 0, LDS_KBUF = 3 * SHM_V, LDS_WS = LDS_KBUF + 3 * SHM_K, LDS_RPB = LDS_WS + NW * 64 * 4, LDS_END = LDS_RPB + 2048;
static_assert(LDS_END <= MISC_OFF, "attention LDS");
#define KSWZ128(row, colB) ((row) * 256 + ((colB) ^ (((row) & 15) << 4)))
#define KSWZ64(row, colB)  ((row) * 128 + ((colB) ^ ((((row) >> 1) & 7) << 4)))
#define SBAR() __builtin_amdgcn_sched_barrier(0)
__device__ __forceinline__ int crow(int r, int hi) { return (r & 3) + 8 * (r >> 2) + 4 * hi; }

struct AttnP {
    const bf16* U; const bf16* QM; const bf16* KVM; bf16* MIX; float* O1; float* O2;
    const f32x2* ropeM; const float* rpb  ;
};

template <int MODE> struct Cfg;
template <> struct Cfg<MODE_MLA>  { static constexpr float SCALE = 0.07216878364870322f; static constexpr int NQ = 12; };
template <> struct Cfg<MODE_NA>   { static constexpr float SCALE = 0.08838834764831845f; static constexpr int NQ = 8; };
template <> struct Cfg<MODE_DIFF> { static constexpr float SCALE = 0.125f;               static constexpr int NQ = 4; };

template <int MODE>
__device__ __forceinline__ void partialSM(f32x16& p0, f32x16& p1, float& m_reg, float& mn, float& alpha) {
    constexpr float SCALE = Cfg<MODE>::SCALE, C = SCALE * LOG2E;
    float pmax = p0[0];
#pragma unroll
    for (int r = 1; r < 16; ++r) pmax = fmaxf(pmax, p0[r]);
#pragma unroll
    for (int r = 0; r < 16; ++r) pmax = fmaxf(pmax, p1[r]);
    { auto rr = __builtin_amdgcn_permlane32_swap(__float_as_uint(pmax), __float_as_uint(pmax), false, false);
      pmax = fmaxf(__uint_as_float(rr[0]), __uint_as_float(rr[1])); }
    if (__builtin_expect(__all(pmax - m_reg <= THR / SCALE), 1)) { mn = m_reg; alpha = 1.f; }
    else { mn = fmaxf(m_reg, pmax); alpha = __builtin_amdgcn_exp2f((m_reg - mn) * C); m_reg = mn; }
    const float mnC = -mn * C;
#pragma unroll
    for (int r = 0; r < 16; ++r) p0[r] = fmaf(p0[r], C, mnC);
#pragma unroll
    for (int r = 0; r < 16; ++r) p1[r] = fmaf(p1[r], C, mnC);
#pragma unroll
    for (int r = 0; r < 16; ++r) p0[r] = __builtin_amdgcn_exp2f(p0[r]);
}
__device__ __forceinline__ void finishSM(f32x16& p0, f32x16& p1, float alpha, float& l_reg, bf16x8& pa0, bf16x8& pa1, bf16x8& pa2, bf16x8& pa3) {
#pragma unroll
    for (int r = 0; r < 16; ++r) p1[r] = __builtin_amdgcn_exp2f(p1[r]);
    float ps = 0;
#pragma unroll
    for (int r = 0; r < 16; ++r) ps += p0[r];
#pragma unroll
    for (int r = 0; r < 16; ++r) ps += p1[r];
    { auto rr = __builtin_amdgcn_permlane32_swap(__float_as_uint(ps), __float_as_uint(ps), false, false);
      ps = __uint_as_float(rr[0]) + __uint_as_float(rr[1]); }
    l_reg = l_reg * alpha + ps;
#define PK4(P, BASE, OUT) do { unsigned a0 = cvt_pk_bf16(P[BASE + 0], P[BASE + 1]), a1 = cvt_pk_bf16(P[BASE + 2], P[BASE + 3]);   \
    unsigned b0 = cvt_pk_bf16(P[BASE + 4], P[BASE + 5]), b1 = cvt_pk_bf16(P[BASE + 6], P[BASE + 7]);                              \
    auto r0 = __builtin_amdgcn_permlane32_swap(a0, b0, false, false); auto r1 = __builtin_amdgcn_permlane32_swap(a1, b1, false, false); \
    u32x4 w = {r0[0], r1[0], r0[1], r1[1]}; OUT = __builtin_bit_cast(bf16x8, w); } while (0)
    PK4(p0, 0, pa0); PK4(p0, 8, pa1); PK4(p1, 0, pa2); PK4(p1, 8, pa3);
#undef PK4
}
#ifndef QK_PD
#define QK_PD 3
#endif
#ifndef ATT2
#define ATT2 4
#endif
#ifndef ATT_GLDS
#define ATT_GLDS 1
#endif
template <int MODE, int D0>
__device__ __forceinline__ void kfrag(const LAS char* Kb, int r32, int hi, bf16x8& b0, bf16x8& b1) {
    if constexpr (MODE == MODE_DIFF) { constexpr int cbase = D0 * 32; const int cb = cbase + hi * 16;
        b0 = *(const LAS bf16x8*)(Kb + KSWZ64(r32, cb)); b1 = *(const LAS bf16x8*)(Kb + KSWZ64(32 + r32, cb)); }
    else if constexpr (D0 < 8) { const int cb = D0 * 32 + hi * 16;
        b0 = *(const LAS bf16x8*)(Kb + KSWZ128(r32, cb)); b1 = *(const LAS bf16x8*)(Kb + KSWZ128(32 + r32, cb)); }
    else { const int cb = (D0 - 8) * 32 + hi * 16; const LAS char* Kr = Kb + 16384;
        b0 = *(const LAS bf16x8*)(Kr + KSWZ64(r32, cb)); b1 = *(const LAS bf16x8*)(Kr + KSWZ64(32 + r32, cb)); }
}
template <int MODE, int D0, int NS>
__device__ __forceinline__ void qk_step(f32x16& p0, f32x16& p1, const LAS char* Kb, const bf16x8* qr, int r32, int hi, bf16x8 (&f0)[NS], bf16x8 (&f1)[NS]) {
    if constexpr (D0 < NS) {
        if constexpr (D0 + QK_PD < NS) kfrag<MODE, D0 + QK_PD>(Kb, r32, hi, f0[D0 + QK_PD], f1[D0 + QK_PD]);
        p0 = __builtin_amdgcn_mfma_f32_32x32x16_bf16(f0[D0], qr[D0], p0, 0, 0, 0);
        p1 = __builtin_amdgcn_mfma_f32_32x32x16_bf16(f1[D0], qr[D0], p1, 0, 0, 0);
        SBAR();
        qk_step<MODE, D0 + 1, NS>(p0, p1, Kb, qr, r32, hi, f0, f1);
    }
}
template <int MODE>
__device__ __forceinline__ void qkt(f32x16& p0, f32x16& p1, const LAS char* Kb, const bf16x8* qr, int r32, int hi) {
    constexpr int NS = Cfg<MODE>::NQ;
    p0 = f32x16{}; p1 = f32x16{};
    bf16x8 f0[NS], f1[NS];
    kfrag<MODE, 0>(Kb, r32, hi, f0[0], f1[0]);
    if constexpr (QK_PD > 1 && NS > 1) kfrag<MODE, 1>(Kb, r32, hi, f0[1], f1[1]);
    if constexpr (QK_PD > 2 && NS > 2) kfrag<MODE, 2>(Kb, r32, hi, f0[2], f1[2]);
    if constexpr (QK_PD > 3 && NS > 3) kfrag<MODE, 3>(Kb, r32, hi, f0[3], f1[3]);
    SBAR();
    qk_step<MODE, 0, NS>(p0, p1, Kb, qr, r32, hi, f0, f1);
}
__device__ __forceinline__ int v_st(int k, int c) { const int kk = (k & ~0xC) | ((k & 4) << 1) | ((k & 8) >> 1); return ((kk >> 3) * 4 + (c >> 5)) * 512 + ((kk & 7) * 32 + (c & 31)) * 2; }
__device__ __forceinline__ int v_rd_base(int lane) { return ((lane & 3) << 3) | (((lane >> 2) & 3) << 6) | (((lane >> 4) & 1) << 5) | (((lane >> 5) & 1) << 8); }
constexpr int v_rd_off(int d0, int ks, int half) { return d0 * 512 + ks * 4096 + half * 2048; }
template <int OFF> __device__ __forceinline__ s16x4 tr_read(int vb) {
    s16x4 r; asm volatile("ds_read_b64_tr_b16 %0, %1 offset:%2" : "=&v"(r) : "v"(vb), "i"(OFF) : "memory"); return r;
}
template <int D0> __device__ __forceinline__ void pv_one(f32x16& od, int vb, bf16x8 pa0, bf16x8 pa1, bf16x8 pa2, bf16x8 pa3) {
    const s16x4 l0 = tr_read<v_rd_off(D0, 0, 0)>(vb), h0 = tr_read<v_rd_off(D0, 0, 1)>(vb), l1 = tr_read<v_rd_off(D0, 1, 0)>(vb), h1 = tr_read<v_rd_off(D0, 1, 1)>(vb);
    const s16x4 l2 = tr_read<v_rd_off(D0, 2, 0)>(vb), h2 = tr_read<v_rd_off(D0, 2, 1)>(vb), l3 = tr_read<v_rd_off(D0, 3, 0)>(vb), h3 = tr_read<v_rd_off(D0, 3, 1)>(vb);
    asm volatile("s_waitcnt lgkmcnt(0)" ::: "memory"); SBAR();
#define PK(L, H) (bf16x8){L[0], L[1], L[2], L[3], H[0], H[1], H[2], H[3]}
    od = __builtin_amdgcn_mfma_f32_32x32x16_bf16(pa0, PK(l0, h0), od, 0, 0, 0);
    od = __builtin_amdgcn_mfma_f32_32x32x16_bf16(pa1, PK(l1, h1), od, 0, 0, 0);
    od = __builtin_amdgcn_mfma_f32_32x32x16_bf16(pa2, PK(l2, h2), od, 0, 0, 0);
    od = __builtin_amdgcn_mfma_f32_32x32x16_bf16(pa3, PK(l3, h3), od, 0, 0, 0);
#undef PK
}
__device__ __forceinline__ void pv_d0(f32x16* o, int vb, bf16x8 pa0, bf16x8 pa1, bf16x8 pa2, bf16x8 pa3) {
    pv_one<0>(o[0], vb, pa0, pa1, pa2, pa3); pv_one<1>(o[1], vb, pa0, pa1, pa2, pa3); pv_one<2>(o[2], vb, pa0, pa1, pa2, pa3); pv_one<3>(o[3], vb, pa0, pa1, pa2, pa3);
}
__device__ __forceinline__ void na_bias_mask(f32x16& p0, f32x16& p1, const LAS float* rpbL, int kr, int rq, int qc, int hi) {
    constexpr float INVS = 11.313708498984761f;
    const int r0 = min(max(rq - 4, 0), 56);
    const bool tv = (kr >= r0) && (kr < r0 + 8);
    const int dr = min(max(kr - rq + 7, 0), 14);
    const int c0 = min(max(qc - 8, 0), 48);
    const LAS float* row = rpbL + dr * 31;
    const float NINF = -__builtin_huge_valf();
#pragma unroll
    for (int r = 0; r < 16; ++r) { const int kc = crow(r, hi);
        const bool ok = tv && kc >= c0 && kc < c0 + 16; const int ix = min(max(kc - qc + 15, 0), 30); const float bv = row[ix]; p0[r] = ok ? fmaf(bv, INVS, p0[r]) : NINF; }
    SBAR();
#pragma unroll
    for (int r = 0; r < 16; ++r) { const int kc2 = crow(r, hi) + 32;
        const bool ok = tv && kc2 >= c0 && kc2 < c0 + 16; const int ix = min(max(kc2 - qc + 15, 0), 30); const float bv = row[ix]; p1[r] = ok ? fmaf(bv, INVS, p1[r]) : NINF; }
}

template <int MODE, int PASS = 0>
__device__ __forceinline__ void attn_unit(const AttnP& P, const int uid, LAS char* lds) {
    constexpr int NQ = Cfg<MODE>::NQ;
    constexpr int NH = (MODE == MODE_MLA) ? 8 : 4;
    int tid = tid_x(); asm volatile("" : "+v"(tid));
    const int wid = tid >> 6, lane = tid & 63, r32 = lane & 31, hi = lane >> 5;
    const int qb = uid & 15, h = (uid >> 4) % NH, b = (uid >> 4) / NH;
    const int tok0 = b * SEQ;
    const int qrow = tok0 + qb * 256 + wid * 32 + r32;
    LAS char* V_lds = lds + LDS_VBUF; LAS char* K_lds = lds + LDS_KBUF;
    LAS float* ws = (LAS float*)(lds + LDS_WS) + wid * 64; LAS float* li_l = ws; LAS float* al_l = ws + 32;
    LAS float* rpbL = (LAS float*)(lds + LDS_RPB);
    const int sr = tid >> 4, sc = (tid & 15) * 8, vst0 = v_st(sr, sc), vst1 = v_st(32 + sr, sc);
    const int sr64 = tid >> 3, sc64 = (tid & 7) * 8;
    const int vb0 = (int)(unsigned)(uintptr_t)V_lds + v_rd_base(lane);
    int NT = 64, kbase = tok0;
    int rq = 0, qc = 0, kr_lo = 0;
    if constexpr (MODE == MODE_NA) { const int rq0 = qb * 4; kr_lo = min(min(max(rq0 - 4, 0), 56), 52); NT = 12; kbase = tok0 + kr_lo * 64; rq = rq0 + (wid >> 1); qc = (wid & 1) * 32 + r32;
        for (int i = tid; i < 15 * 31; i += 512) rpbL[i] = P.rpb[h * 465 + i];
        __syncthreads(); }
    const bf16* Kg; const bf16* Vg; const bf16* Kg2 = nullptr; int ldk, ldv;
    if constexpr (MODE == MODE_MLA) { Kg = P.KVM + h * 256; Vg = P.KVM + h * 256 + 128; Kg2 = P.U + U_KR; ldk = KVW; ldv = KVW; }
    else if constexpr (MODE == MODE_NA) { Kg = P.U + U_NA + 512 + h * 128; Vg = P.U + U_NA + 1024 + h * 128; ldk = UW; ldv = UW; }
    else { Kg = P.U + U_DF + 512 + h * 128; Vg = P.U + U_DF + 1024 + h * 128; ldk = UW; ldv = UW; }

    constexpr int pass = PASS;
    constexpr bool HALF_OFFSET = false;
    {
        float m_reg = -1e30f, l_reg = 0; f32x16 o[4] = {}; bf16x8 qr[NQ];
        if constexpr (MODE == MODE_MLA) {
            const bf16* Qw = P.QM + (size_t)qrow * QMW + h * 192 + hi * 8;
#pragma unroll
            for (int d0 = 0; d0 < 12; ++d0) qr[d0] = *(const bf16x8*)(Qw + d0 * 16);
            const f32x2* rt = P.ropeM + (size_t)(qrow & (SEQ - 1)) * 32;
#pragma unroll
            for (int g = 0; g < 2; ++g) {
                bf16x8 x1 = qr[8 + g], x2 = qr[10 + g];
#pragma unroll
                for (int e = 0; e < 8; ++e) { const f32x2 cs = rt[g * 16 + hi * 8 + e];
                    const float a = bf2f((unsigned short)x1[e]), c = bf2f((unsigned short)x2[e]);
                    const float ra = a * cs.x - c * cs.y, rc = c * cs.x + a * cs.y;
                    x1[e] = (short)(cvt_pk_bf16(ra, 0.f) & 0xffffu); x2[e] = (short)(cvt_pk_bf16(rc, 0.f) & 0xffffu); }
                qr[8 + g] = x1; qr[10 + g] = x2;
            }
        } else if constexpr (MODE == MODE_NA) {
            const bf16* Qw = P.U + (size_t)qrow * UW + U_NA + h * 128 + hi * 8;
#pragma unroll
            for (int d0 = 0; d0 < 8; ++d0) qr[d0] = *(const bf16x8*)(Qw + d0 * 16);
        } else {
            const bf16* Qw = P.U + (size_t)qrow * UW + U_DF + h * 128 + pass * 64 + hi * 8;
#pragma unroll
            for (int d0 = 0; d0 < 4; ++d0) qr[d0] = *(const bf16x8*)(Qw + d0 * 16);
        }
        const bf16* Kp = (MODE == MODE_DIFF) ? Kg + pass * 64 : Kg;
        bf16x8 s_v0, s_v1, s_k0, s_k1, s_k2;
        const unsigned voffA = (unsigned)(sr * ldv + sc) * 2u, voffB = (unsigned)((32 + sr) * ldv + sc) * 2u;
        const unsigned koffA = (unsigned)(sr * ldk + sc) * 2u, koffB = (unsigned)((32 + sr) * ldk + sc) * 2u;
        const unsigned koff64 = (unsigned)(sr64 * ldk + sc64) * 2u, k2off = (unsigned)(sr64 * UW + sc64) * 2u;
#define SLOAD(t) do { const size_t kt = (size_t)(kbase + (t) * 64); const bf16* Vt = Vg + kt * ldv; const bf16* Kt = Kp + kt * ldk; \
        s_v0 = ldg_b128(Vt, voffA); s_v1 = ldg_b128(Vt, voffB); \
        if constexpr (MODE == MODE_DIFF) { s_k0 = ldg_b128(Kt, koff64); } \
        else { s_k0 = ldg_b128(Kt, koffA); s_k1 = ldg_b128(Kt, koffB); \
               if constexpr (MODE == MODE_MLA) s_k2 = ldg_b128(Kg2 + kt * UW, k2off); } } while (0)
#define SWRITE(bf) do { LAS char* Vb_ = V_lds + (bf) * SHM_V; LAS char* Kb_ = K_lds + (bf) * SHM_K; \
        *(LAS bf16x8*)(Vb_ + vst0) = s_v0; *(LAS bf16x8*)(Vb_ + vst1) = s_v1; \
        if constexpr (MODE == MODE_DIFF) { *(LAS bf16x8*)(Kb_ + KSWZ64(sr64, sc64 * 2)) = s_k0; } \
        else { *(LAS bf16x8*)(Kb_ + KSWZ128(sr, sc * 2)) = s_k0; *(LAS bf16x8*)(Kb_ + KSWZ128(32 + sr, sc * 2)) = s_k1; \
               if constexpr (MODE == MODE_MLA) *(LAS bf16x8*)(Kb_ + 16384 + KSWZ64(sr64, sc64 * 2)) = s_k2; } } while (0)
#define RESC(a) do { if (__any((a) < 1.f)) { if (hi == 0) al_l[r32] = (a); asm volatile("s_waitcnt lgkmcnt(0)" ::: "memory"); \
        _Pragma("unroll") for (int d = 0; d < 4; ++d) _Pragma("unroll") for (int r = 0; r < 16; ++r) o[d][r] *= al_l[crow(r, hi)]; } } while (0)
#define NAMASK(pa_, pb_, t) do { if constexpr (MODE == MODE_NA) na_bias_mask(pa_, pb_, rpbL, kr_lo + (t), rq, qc, hi); } while (0)
        f32x16 p0, p1; float mn, al; bf16x8 pa0, pa1, pa2, pa3;
        if constexpr (HALF_OFFSET) {
        SLOAD(0); VM_WAIT(); SWRITE(0); SLOAD(1); __syncthreads();
        const int grp = __builtin_amdgcn_readfirstlane(wid) >> 2;
#pragma unroll 1
        for (int sl = 0; sl < 2 * NT + 1; ++sl) {
            if (sl & 1) { const int t = sl >> 1; if (t + 1 < NT) { VM_WAIT(); SWRITE((t + 1) & 1); } if (t + 2 < NT) SLOAD(t + 2); }
            SBAR();
            const int rel = sl - grp, tt = rel >> 1;
            if (rel >= 0 && tt < NT) {
                bool act = true;
                if constexpr (MODE == MODE_NA) { const int kr = kr_lo + tt, r0w = min(max(rq - 4, 0), 56); act = (kr >= r0w) && (kr < r0w + 8); }
                if (act) {
                    if ((rel & 1) == 0) { qkt<MODE>(p0, p1, K_lds + (tt & 1) * SHM_K, qr, r32, hi); NAMASK(p0, p1, tt); }
                    else { partialSM<MODE>(p0, p1, m_reg, mn, al);
                        RESC(al);
                        finishSM(p0, p1, al, l_reg, pa0, pa1, pa2, pa3); SBAR();
                        pv_d0(o, vb0 + (tt & 1) * SHM_V, pa0, pa1, pa2, pa3); }
                }
            }
            __syncthreads();
        }
        } else if constexpr (ATT_GLDS && ((ATT2 >> MODE) & 1) && MODE != MODE_NA) {
        unsigned gsv[2], gsk[2], gsk2 = 0u;
#pragma unroll
        for (int i = 0; i < 2; ++i) { const int a = (i * 512 + tid) * 16;
            { const int sub = a >> 9, within = a & 511; const int kk = (sub >> 2) * 8 + (within >> 6); const int k = (kk & ~0xC) | ((kk & 4) << 1) | ((kk & 8) >> 1);
              const int c = (sub & 3) * 32 + ((within & 63) >> 1); gsv[i] = (unsigned)(k * ldv + c) * 2u; }
            if constexpr (MODE == MODE_DIFF) { if (i == 0) { const int row = a >> 7, ch = ((a >> 4) & 7) ^ ((row >> 1) & 7); gsk[0] = (unsigned)(row * ldk + ch * 8) * 2u; } gsk[1] = 0u; }
            else { const int row = a >> 8, ch = ((a >> 4) & 15) ^ (row & 15); gsk[i] = (unsigned)(row * ldk + ch * 8) * 2u; } }
        if constexpr (MODE == MODE_MLA) { const int a = tid * 16, row = a >> 7, ch = ((a >> 4) & 7) ^ ((row >> 1) & 7); gsk2 = (unsigned)(row * UW + ch * 8) * 2u; }
        const unsigned ldsw = (unsigned)__builtin_amdgcn_readfirstlane(wid) * 1024u;
#define GLDS3(t) do { const int bf_ = (t) % 3; const size_t kt = (size_t)(kbase + (t) * 64); const char* Vt = (const char*)(Vg + kt * ldv); const char* Kt = (const char*)(Kp + kt * ldk); \
        LAS char* Vb_ = V_lds + bf_ * SHM_V + ldsw; LAS char* Kb_ = K_lds + bf_ * SHM_K + ldsw; \
        __builtin_amdgcn_global_load_lds((const unsigned*)(Vt + gsv[0]), (LAS unsigned*)(Vb_), 16, 0, 0); __builtin_amdgcn_global_load_lds((const unsigned*)(Vt + gsv[1]), (LAS unsigned*)(Vb_ + 8192), 16, 0, 0); \
        __builtin_amdgcn_global_load_lds((const unsigned*)(Kt + gsk[0]), (LAS unsigned*)(Kb_), 16, 0, 0); \
        if constexpr (MODE != MODE_DIFF) __builtin_amdgcn_global_load_lds((const unsigned*)(Kt + gsk[1]), (LAS unsigned*)(Kb_ + 8192), 16, 0, 0); \
        if constexpr (MODE == MODE_MLA) __builtin_amdgcn_global_load_lds((const unsigned*)((const char*)(Kg2 + kt * UW) + gsk2), (LAS unsigned*)(Kb_ + 16384), 16, 0, 0); } while (0)
#define KB3(t) (K_lds + ((t) % 3) * SHM_K)
#define VB3(t) (vb0 + ((t) % 3) * SHM_V)
        f32x16 pB0, pB1; float mnB, alB;
        GLDS3(0); GLDS3(1); VM_WAIT(); __syncthreads();
        qkt<MODE>(p0, p1, KB3(0), qr, r32, hi); partialSM<MODE>(p0, p1, m_reg, mn, al);
#pragma unroll 1
        for (int j = 1; j + 1 < NT; j += 2) {
            GLDS3(j + 1);
            SBAR(); qkt<MODE>(pB0, pB1, KB3(j), qr, r32, hi);
            finishSM(p0, p1, al, l_reg, pa0, pa1, pa2, pa3); SBAR();
            pv_d0(o, VB3(j - 1), pa0, pa1, pa2, pa3); partialSM<MODE>(pB0, pB1, m_reg, mnB, alB);
            RESC(alB); VM_WAIT(); __syncthreads();
            if (j + 2 < NT) GLDS3(j + 2);
            SBAR(); qkt<MODE>(p0, p1, KB3(j + 1), qr, r32, hi);
            finishSM(pB0, pB1, alB, l_reg, pa0, pa1, pa2, pa3); SBAR();
            pv_d0(o, VB3(j), pa0, pa1, pa2, pa3); partialSM<MODE>(p0, p1, m_reg, mn, al);
            RESC(al); VM_WAIT(); __syncthreads();
        }
        SBAR(); qkt<MODE>(pB0, pB1, KB3(NT - 1), qr, r32, hi);
        finishSM(p0, p1, al, l_reg, pa0, pa1, pa2, pa3); SBAR();
        pv_d0(o, VB3(NT - 2), pa0, pa1, pa2, pa3); partialSM<MODE>(pB0, pB1, m_reg, mnB, alB);
        RESC(alB);
        finishSM(pB0, pB1, alB, l_reg, pa0, pa1, pa2, pa3); SBAR();
        pv_d0(o, VB3(NT - 1), pa0, pa1, pa2, pa3);
        __syncthreads();
#undef GLDS3
#undef KB3
#undef VB3
        } else if constexpr (ATT_GLDS) {
        unsigned gsv[2], gsk[2], gsk2 = 0u;
#pragma unroll
        for (int i = 0; i < 2; ++i) { const int a = (i * 512 + tid) * 16;
            { const int sub = a >> 9, within = a & 511; const int kk = (sub >> 2) * 8 + (within >> 6); const int k = (kk & ~0xC) | ((kk & 4) << 1) | ((kk & 8) >> 1);
              const int c = (sub & 3) * 32 + ((within & 63) >> 1); gsv[i] = (unsigned)(k * ldv + c) * 2u; }
            if constexpr (MODE == MODE_DIFF) { if (i == 0) { const int row = a >> 7, ch = ((a >> 4) & 7) ^ ((row >> 1) & 7); gsk[0] = (unsigned)(row * ldk + ch * 8) * 2u; } gsk[1] = 0u; }
            else { const int row = a >> 8, ch = ((a >> 4) & 15) ^ (row & 15); gsk[i] = (unsigned)(row * ldk + ch * 8) * 2u; } }
        if constexpr (MODE == MODE_MLA) { const int a = tid * 16, row = a >> 7, ch = ((a >> 4) & 7) ^ ((row >> 1) & 7); gsk2 = (unsigned)(row * UW + ch * 8) * 2u; }
        const unsigned ldsw = (unsigned)__builtin_amdgcn_readfirstlane(wid) * 1024u;
#define GLDS(t, bf) do { const size_t kt = (size_t)(kbase + (t) * 64); const char* Vt = (const char*)(Vg + kt * ldv); const char* Kt = (const char*)(Kp + kt * ldk); \
        LAS char* Vb_ = V_lds + (bf) * SHM_V + ldsw; LAS char* Kb_ = K_lds + (bf) * SHM_K + ldsw; \
        __builtin_amdgcn_global_load_lds((const unsigned*)(Vt + gsv[0]), (LAS unsigned*)(Vb_), 16, 0, 0); __builtin_amdgcn_global_load_lds((const unsigned*)(Vt + gsv[1]), (LAS unsigned*)(Vb_ + 8192), 16, 0, 0); \
        __builtin_amdgcn_global_load_lds((const unsigned*)(Kt + gsk[0]), (LAS unsigned*)(Kb_), 16, 0, 0); \
        if constexpr (MODE != MODE_DIFF) __builtin_amdgcn_global_load_lds((const unsigned*)(Kt + gsk[1]), (LAS unsigned*)(Kb_ + 8192), 16, 0, 0); \
        if constexpr (MODE == MODE_MLA) __builtin_amdgcn_global_load_lds((const unsigned*)((const char*)(Kg2 + kt * UW) + gsk2), (LAS unsigned*)(Kb_ + 16384), 16, 0, 0); } while (0)
        GLDS(0, 0); VM_WAIT(); __syncthreads();
#pragma unroll 1
        for (int t = 0; t < NT; ++t) {
            const int bf = t & 1;
            if (t + 1 < NT) GLDS(t + 1, bf ^ 1);
            SBAR();
            bool act = true;
            if constexpr (MODE == MODE_NA) { const int kr = kr_lo + t, r0w = min(max(rq - 4, 0), 56); act = (kr >= r0w) && (kr < r0w + 8); }
            if (act) {
            qkt<MODE>(p0, p1, K_lds + bf * SHM_K, qr, r32, hi); NAMASK(p0, p1, t);
            partialSM<MODE>(p0, p1, m_reg, mn, al);
            RESC(al);
            finishSM(p0, p1, al, l_reg, pa0, pa1, pa2, pa3); SBAR();
            pv_d0(o, vb0 + bf * SHM_V, pa0, pa1, pa2, pa3);
            }
            VM_WAIT();
            __syncthreads();
        }
#undef GLDS
        } else {
        SLOAD(0); VM_WAIT(); SWRITE(0); SLOAD(1); __syncthreads();
#pragma unroll 1
        for (int t = 0; t < NT; ++t) {
            const int bf = t & 1;
            if (t + 1 < NT) { VM_WAIT(); SWRITE(bf ^ 1); }
            SBAR();
            bool act = true;
            if constexpr (MODE == MODE_NA) { const int kr = kr_lo + t, r0w = min(max(rq - 4, 0), 56); act = (kr >= r0w) && (kr < r0w + 8); }
            if (act) {
            qkt<MODE>(p0, p1, K_lds + bf * SHM_K, qr, r32, hi); NAMASK(p0, p1, t);
            partialSM<MODE>(p0, p1, m_reg, mn, al);
            RESC(al);
            finishSM(p0, p1, al, l_reg, pa0, pa1, pa2, pa3); SBAR();
            }
            if (t + 2 < NT) SLOAD(t + 2);
            SBAR();
            if (act) pv_d0(o, vb0 + bf * SHM_V, pa0, pa1, pa2, pa3);
            __syncthreads();
        }
        }
        int r32e = r32, hie = hi; asm volatile("" : "+v"(r32e), "+v"(hie));
        if (hi == 0) li_l[r32] = l_reg; asm volatile("s_waitcnt lgkmcnt(0)" ::: "memory");
#pragma unroll
        for (int r = 0; r < 16; ++r) { const float rl = __builtin_amdgcn_rcpf(li_l[crow(r, hie)]);
#pragma unroll
            for (int d0 = 0; d0 < 4; ++d0) o[d0][r] *= rl; }
        const int orow0 = tok0 + qb * 256 + __builtin_amdgcn_readfirstlane(wid) * 32;
        if constexpr (MODE == MODE_DIFF) {
            float* O1b = (pass == 0 ? P.O1 : P.O2) + (size_t)orow0 * 512 + h * 128;
            const unsigned o1off = (unsigned)(hie * 4 * 512 + r32e) * 4u;
#pragma unroll
            for (int r = 0; r < 16; ++r)
#pragma unroll
                for (int d0 = 0; d0 < 4; ++d0) stg_f32(O1b + crow(r, 0) * 512, o1off + (unsigned)(d0 * 128), o[d0][r]);
        } else {
            bf16* Mb = P.MIX + (size_t)orow0 * DM + ((MODE == MODE_MLA) ? h * 128 : 1024 + h * 128);
            const unsigned moff = (unsigned)(hie * 4 * DM + r32e) * 2u;
#pragma unroll
            for (int r = 0; r < 16; ++r)
#pragma unroll
                for (int d0 = 0; d0 < 4; ++d0) stg_u16(Mb + crow(r, 0) * DM, moff + (unsigned)(d0 * 64), (unsigned short)(cvt_pk_bf16(o[d0][r], 0.f) & 0xffffu));
        }
        __syncthreads();
#undef SLOAD
#undef SWRITE
#undef RESC
#undef NAMASK
    }
}
}

struct Args {
    const float* in[28]; float* out; unsigned char* ws; int ph_lo, ph_hi;
};
typedef const __attribute__((address_space(4))) unsigned char* kaptr;
struct KA {
    kaptr p;
    __device__ __forceinline__ const float* in(int i) const { return *(const float* const __attribute__((address_space(4)))*)(p + 8 * i); }
    __device__ __forceinline__ float* out() const { return *(float* const __attribute__((address_space(4)))*)(p + 224); }
    __device__ __forceinline__ unsigned char* ws() const { return *(unsigned char* const __attribute__((address_space(4)))*)(p + 232); }
    __device__ __forceinline__ int ph_lo() const { return *(const __attribute__((address_space(4))) int*)(p + 240); }
    __device__ __forceinline__ int ph_hi() const { return *(const __attribute__((address_space(4))) int*)(p + 244); }
};
__device__ __forceinline__ KA fresh_ka() { kaptr p = (kaptr)__builtin_amdgcn_kernarg_segment_ptr(); asm volatile("" : "+s"(p)); return KA{p}; }
static_assert(sizeof(Args) == 248, "Args layout");
struct Frame {
    LAS unsigned char* lds; volatile LAS unsigned* MISC; unsigned* ctl;
    int tid, lane, wave, G, gw, NGW;
};
constexpr int NPHASE = 2 + 8 * NLAYER;
#ifndef GEMM_SP2
#define GEMM_SP2 true
#endif
#ifndef CONV_QUOTA
#define CONV_QUOTA 7
#endif

struct CvtDesc { const float* src; unsigned char* dst; int N, dKB, f8; };
__device__ __forceinline__ void cvt_load(const CvtDesc& d, float (&t)[64], int lane) {
    const float* p = d.src + (size_t)(lane >> 4) * d.N + 4 * (lane & 15);
#pragma unroll
    for (int i = 0; i < 16; ++i) { const f32x4 v = __builtin_nontemporal_load((const f32x4*)(p + (size_t)(4 * i) * d.N));
        t[4 * i] = v.x; t[4 * i + 1] = v.y; t[4 * i + 2] = v.z; t[4 * i + 3] = v.w; }
}
__device__ __forceinline__ void cvt_finish(const CvtDesc& d, const float (&t)[64], LAS float* scr, int lane) {
    LAS float* sw = scr + (lane >> 4) * 65 + 4 * (lane & 15);
#pragma unroll
    for (int i = 0; i < 16; ++i) { sw[(4 * i) * 65] = t[4 * i]; sw[(4 * i) * 65 + 1] = t[4 * i + 1]; sw[(4 * i) * 65 + 2] = t[4 * i + 2]; sw[(4 * i) * 65 + 3] = t[4 * i + 3]; }
    LDS_WAIT();
    const int c = lane & 7;
    if (d.f8) {
#pragma unroll
        for (int j = 0; j < 8; ++j) { const int n = (lane >> 3) + 8 * j; const LAS float* s = scr + (8 * c) * 65 + n;
            int a = __builtin_amdgcn_cvt_pk_fp8_f32(clamp8(s[0 * 65] * W8_SCALE), clamp8(s[1 * 65] * W8_SCALE), 0, false); a = __builtin_amdgcn_cvt_pk_fp8_f32(clamp8(s[2 * 65] * W8_SCALE), clamp8(s[3 * 65] * W8_SCALE), a, true);
            int b = __builtin_amdgcn_cvt_pk_fp8_f32(clamp8(s[4 * 65] * W8_SCALE), clamp8(s[5 * 65] * W8_SCALE), 0, false); b = __builtin_amdgcn_cvt_pk_fp8_f32(clamp8(s[6 * 65] * W8_SCALE), clamp8(s[7 * 65] * W8_SCALE), b, true);
            __builtin_nontemporal_store((u32x2){(unsigned)a, (unsigned)b}, (u32x2*)(d.dst + (size_t)n * d.dKB + 8 * c)); }
    } else {
#pragma unroll
        for (int j = 0; j < 8; ++j) { const int n = (lane >> 3) + 8 * j; const LAS float* s = scr + (8 * c) * 65 + n;
            u32x4 o; o.x = cvt_pk_bf16(s[0 * 65], s[1 * 65]); o.y = cvt_pk_bf16(s[2 * 65], s[3 * 65]); o.z = cvt_pk_bf16(s[4 * 65], s[5 * 65]); o.w = cvt_pk_bf16(s[6 * 65], s[7 * 65]);
            __builtin_nontemporal_store(o, (u32x4*)(d.dst + (size_t)n * d.dKB + 16 * c)); }
    }
    LDS_WAIT();
}
__device__ __forceinline__ void cvt_item(const float* W, int N, int k0, int n0, bf16* WT, size_t dst_row0, int dK, LAS float* scr, int lane) {
    CvtDesc d; d.src = W + (size_t)k0 * N + n0; d.dst = (unsigned char*)(WT + dst_row0 * dK + k0); d.N = N; d.dKB = dK * 2; d.f8 = 0;
    float t[64]; cvt_load(d, t, lane); cvt_finish(d, t, scr, lane);
}

__device__ __forceinline__ void sincos_rev(double t, float& c, float& s) {
    const int q = (int)(t * 4.0 + 0.5);
    const double r = (t - 0.25 * q) * 6.283185307179586476925;
    const double r2 = r * r;
    const double sn = r * (1.0 + r2 * (-1.0 / 6 + r2 * (1.0 / 120 + r2 * (-1.0 / 5040 + r2 * (1.0 / 362880 + r2 * (-1.0 / 39916800 + r2 * (1.0 / 6227020800.0)))))));
    const double cs = 1.0 + r2 * (-0.5 + r2 * (1.0 / 24 + r2 * (-1.0 / 720 + r2 * (1.0 / 40320 + r2 * (-1.0 / 3628800 + r2 * (1.0 / 479001600.0 + r2 * (-1.0 / 87178291200.0)))))));
    double co, si;
    switch (q & 3) { case 0: co = cs; si = sn; break; case 1: co = -sn; si = cs; break; case 2: co = -cs; si = -sn; break; default: co = sn; si = -cs; break; }
    c = (float)co; s = (float)si;
}

__device__ __forceinline__ void row_stats(const f32x4 (&v)[8], float& mean, float& rstd) {
    float s = 0.f;
#pragma unroll
    for (int j = 0; j < 8; ++j) s += (v[j].x + v[j].y) + (v[j].z + v[j].w);
    mean = wave_sum(s) * (1.f / DM);
    float s2 = 0.f;
#pragma unroll
    for (int j = 0; j < 8; ++j) { const f32x4 d = v[j] - mean; s2 += (d.x * d.x + d.y * d.y) + (d.z * d.z + d.w * d.w); }
    rstd = rsqrtf(wave_sum(s2) * (1.f / DM) + LN_EPS);
}

constexpr int CW_Q = 32768;
constexpr int Q_IG = NE1 * 256, Q_PER_L = 3 * Q_IG, Q_TOTAL = NLAYER * Q_PER_L;
__device__ __forceinline__ CvtDesc conv_expert_desc(const KA& a, unsigned char* ws, int q) {
    const int l = q / Q_PER_L; int r = q - l * Q_PER_L;
    unsigned char* wl = ws + WS_W + (size_t)l * W_LSTRIDE;
    CvtDesc d; d.f8 = (MOE_FP8_LAST && (MOE_FP8_GU_ALL || l == NLAYER - 1)) ? 1 : 0;
    if (MOE_FP8_LAST && MOE_FP8_DOWN_ALL && r >= 2 * Q_IG) d.f8 = 1;
    const int eb = d.f8 ? 1 : 2;
    if (r < 2 * Q_IG) { const int up = r >= Q_IG; if (up) r -= Q_IG; const int e = r >> 8, rr = r & 255, kb = rr >> 3, nb = rr & 7, n0 = nb * 64;
        const float* src = e < 64 ? a.in(up ? 21 : 20) + ((size_t)l * 64 + e) * DM * FFE : a.in(up ? 24 : 23) + (size_t)l * DM * FFE;
        d.src = src + (size_t)(kb * 64) * FFE + n0; d.N = FFE; d.dKB = DM * eb;
        d.dst = wl + W_GU + ((size_t)e * 1024 * DM + (size_t)((n0 >> 7) * 256 + up * 128 + (n0 & 127)) * DM + kb * 64) * eb;
    } else { r -= 2 * Q_IG; const int e = r >> 8, rr = r & 255, kb = rr >> 5, nb = rr & 31;
        const float* src = e < 64 ? a.in(22) + ((size_t)l * 64 + e) * FFE * DM : a.in(25) + (size_t)l * FFE * DM;
        d.src = src + (size_t)(kb * 64) * DM + nb * 64; d.N = DM; d.dKB = FFE * eb;
        d.dst = wl + W_D + ((size_t)e * DM * FFE + (size_t)(nb * 64) * FFE + kb * 64) * eb; }
    return d;
}
__device__ __forceinline__ void conv_expert_item(const KA& a, unsigned char* ws, int q, LAS float* scr, int lane) {
    const CvtDesc d = conv_expert_desc(a, ws, q); float t[64]; cvt_load(d, t, lane); cvt_finish(d, t, scr, lane);
}
__device__ __forceinline__ void conv_drain(const KA& a, unsigned char* ws, LAS unsigned char* lds, int target, int max_claims = 0x7fffffff) {
    volatile LAS unsigned* st = (volatile LAS unsigned*)(lds + MISC_OFF) + 8;
    unsigned* qw = (unsigned*)(ws + WS_CTL) + CW_Q;
    int tl = tid_x(); asm volatile("" : "+v"(tl));
    const int wave = __builtin_amdgcn_readfirstlane(tl >> 6), lane = tl & 63;
    LAS float* scr = (LAS float*)(lds + wave * 16640);
    __syncthreads();
    unsigned ahead = 0xFFFFFFFFu;
    if (tl == 0 && max_claims > 0) { if (xb_ld(qw) < (unsigned)target) ahead = xb_add(qw, 32u); }
    for (int nc = 0; nc < max_claims; ++nc) {
        if (tl == 0) { st[6] = ahead; if (ahead < (unsigned)target && nc + 1 < max_claims) ahead = (ahead + 32u < (unsigned)target) ? xb_add(qw, 32u) : 0xFFFFFFFFu; }
        __syncthreads();
        const unsigned base = st[6];
        if (base < (unsigned)Q_TOTAL) {
            const int q0 = (int)base + wave; const bool v0 = q0 < Q_TOTAL, v1 = q0 + 8 < Q_TOTAL, v2 = q0 + 16 < Q_TOTAL, v3 = q0 + 24 < Q_TOTAL;
            float ta[64], tb[64]; CvtDesc da, db;
            if (v0) { da = conv_expert_desc(a, ws, q0); cvt_load(da, ta, lane); }
            if (v1) { db = conv_expert_desc(a, ws, q0 + 8); cvt_load(db, tb, lane); }
            if (v0) cvt_finish(da, ta, scr, lane);
            if (v2) { da = conv_expert_desc(a, ws, q0 + 16); cvt_load(da, ta, lane); }
            if (v1) cvt_finish(db, tb, scr, lane);
            if (v3) { db = conv_expert_desc(a, ws, q0 + 24); cvt_load(db, tb, lane); }
            if (v2) cvt_finish(da, ta, scr, lane);
            if (v3) cvt_finish(db, tb, scr, lane);
        }
        if (base >= (unsigned)target) break;
        __syncthreads();
    }
    __syncthreads();
}
__device__ __forceinline__ void xcd_barrier_work(const XcdBarrier& b, const KA& a, unsigned char* ws, LAS unsigned char* lds) {
    asm volatile("s_waitcnt vmcnt(0)" ::: "memory");
    __syncthreads();
    volatile LAS unsigned* st = b.st;
    unsigned* bar = b.bar; asm volatile("" : "+s"(bar));
    unsigned* qw = (unsigned*)(ws + WS_CTL) + CW_Q;
    if (tid_x() == 0) {
        __builtin_amdgcn_s_waitcnt(0);
        unsigned nloc = st[0], nx = st[1];
        if (nloc == 0u) { xcd_barrier_complete(bar, b.x, nloc, nx); st[0] = nloc; st[1] = nx; }
        const unsigned old = xb_add(&bar[XB_XSUB(b.x)], 1u);
        const unsigned gen = old / nloc;
        if (old + 1u == (gen + 1u) * nloc) {
            __builtin_amdgcn_fence(__ATOMIC_RELEASE, "agent");
            asm volatile("s_waitcnt vmcnt(0)" ::: "memory");
            const unsigned og = xb_add(&bar[XB_TOP], 1u);
            const unsigned tg = og / nx;
            if (og + 1u == (tg + 1u) * nx) xb_add(&bar[XB_TOPGEN], 1u);
            else XB_SPIN(xb_ld(&bar[XB_TOPGEN]) == tg, bar);
            __builtin_amdgcn_fence(__ATOMIC_ACQUIRE, "agent");
            xb_add(&bar[XB_XGEN(b.x)], 1u);
            asm volatile("s_waitcnt vmcnt(0)" ::: "memory");
            st[4] = 1u;
        } else { st[4] = 0u; st[5] = gen; }
    }
    __syncthreads();
    int tl = tid_x(); asm volatile("" : "+v"(tl));
    const int wave = __builtin_amdgcn_readfirstlane(tl >> 6), lane = tl & 63;
    LAS float* scr = (LAS float*)(lds + wave * 16640);
    unsigned spins = 0;
    while (st[4] == 0u) {
        if (tl == 0) {
            if (xb_ld(&bar[XB_XGEN(b.x)]) != st[5] || xb_ld(&bar[XB_TMO]) != 0u) {
                __builtin_amdgcn_fence(__ATOMIC_ACQUIRE, "agent");
                asm volatile("s_waitcnt vmcnt(0)" ::: "memory");
                st[4] = 1u;
            } else {
                if (++spins > XB_SPIN_CAP) atomicAdd(&bar[XB_TMO], 1u);
                unsigned base = 0xFFFFFFFFu;
                if (st[7] == 0u) { base = xb_add(qw, 8u); if (base >= (unsigned)Q_TOTAL) st[7] = 1u; }
                st[6] = base;
            }
        }
        __syncthreads();
        if (st[4] != 0u) break;
        const unsigned base = st[6];
        if (base < (unsigned)Q_TOTAL) { if (base + wave < (unsigned)Q_TOTAL) conv_expert_item(a, ws, (int)base + wave, scr, lane); }
        else __builtin_amdgcn_s_sleep(4);
        __syncthreads();
    }
    __syncthreads();
}

__device__ __forceinline__ void p0_prologue(Frame& F, const KA& a) {
    unsigned char* ws = a.ws();
    {
        LAS float* sc = (LAS float*)F.lds; LAS float* red = (LAS float*)(F.lds + 16384);
        const float* cin = a.in(1);
        for (int idx = F.tid; idx < 2 * DM; idx += 512) { const float cv = cin[idx]; sc[idx] = cv * __builtin_amdgcn_rcpf(1.f + __builtin_amdgcn_exp2f(-1.4426950408889634f * cv)); }
        __syncthreads();
        for (int task = blockIdx.x; task < 256; task += F.G) {
            const int l = task >> 7, c0 = (task & 127) * 96;
            const float* Wp = a.in(2) + (size_t)l * DM * ADA_W + c0 + F.lane;
            const bool two = F.lane < 32;
            float a00 = 0.f, a01 = 0.f, a10 = 0.f, a11 = 0.f;
            const int kb = F.wave * 256;
#pragma unroll 1
            for (int k0 = 0; k0 < 256; k0 += 32) {
                float w0[32], w1[32];
#pragma unroll
                for (int k = 0; k < 32; ++k) { w0[k] = __builtin_nontemporal_load(Wp + (size_t)(kb + k0 + k) * ADA_W); w1[k] = two ? __builtin_nontemporal_load(Wp + (size_t)(kb + k0 + k) * ADA_W + 64) : 0.f; }
#pragma unroll
                for (int k = 0; k < 32; ++k) { const float s0 = sc[kb + k0 + k], s1 = sc[DM + kb + k0 + k];
                    a00 = fmaf(s0, w0[k], a00); a01 = fmaf(s0, w1[k], a01); a10 = fmaf(s1, w0[k], a10); a11 = fmaf(s1, w1[k], a11); }
            }
            red[(F.wave * 2 + 0) * 96 + F.lane] = a00; red[(F.wave * 2 + 1) * 96 + F.lane] = a10;
            if (two) { red[(F.wave * 2 + 0) * 96 + 64 + F.lane] = a01; red[(F.wave * 2 + 1) * 96 + 64 + F.lane] = a11; }
            __syncthreads();
            if (F.tid < 192) { const int b = F.tid / 96, j = F.tid % 96; float s = 0.f;
#pragma unroll
                for (int w = 0; w < 8; ++w) s += red[(w * 2 + b) * 96 + j];
                ((float*)(ws + WS_ADA))[(size_t)(l * 2 + b) * ADA_W + c0 + j] = s + a.in(3)[(size_t)l * ADA_W + c0 + j]; }
            __syncthreads();
        }
    }
    {
        f32x2* rm = (f32x2*)(ws + WS_ROPEM); f32x2* rd = (f32x2*)(ws + WS_ROPED);
        for (int idx = blockIdx.x * 512 + F.tid; idx < SEQ * 40; idx += F.G * 512) {
            const int pos = idx / 40, j = idx % 40;
            const int jj = j < 32 ? j : j - 32; const double base = j < 32 ? 0.66360123769608848 : 0.19392274474868576;
            double inv = 1.0; for (int q = 0; q < jj; ++q) inv *= base;
            double t = (double)pos * inv * 0.15915494309189533577; t -= floor(t);
            float c, s; sincos_rev(t, c, s);
            if (j < 32) rm[pos * 32 + j] = (f32x2){c, s}; else rd[pos * 8 + jj] = (f32x2){c, s};
        }
    }
    {
        LAS float* scr = (LAS float*)(F.lds + F.wave * 16640);
        constexpr int I_IN = 32 * 61, I_UQ = 8 * 24, I_UKV = 4 * 32, I_O = 32 * 32, I_R = 32;
        constexpr int PER_L = I_IN + I_UQ + I_UKV + I_O + I_R;
        for (int it = F.gw; it < NLAYER * PER_L; it += F.NGW) {
            const int l = it / PER_L; int r = it - l * PER_L;
            unsigned char* wl = ws + WS_W + (size_t)l * W_LSTRIDE;
            if (r < I_IN) { const int kb = r / 61, nb = r % 61, n0 = nb * 64; const int d0 = n0 < 832 ? n0 : n0 + 192;
                cvt_item(a.in(4) + (size_t)l * DM * 3904, 3904, kb * 64, n0, (bf16*)(wl + W_IN), d0, DM, scr, F.lane); continue; } r -= I_IN;
            if (r < I_UQ) { const int kb = r / 24, nb = r % 24;
                cvt_item(a.in(6) + (size_t)l * 512 * 1536, 1536, kb * 64, nb * 64, (bf16*)(wl + W_UQ), nb * 64, 512, scr, F.lane); continue; } r -= I_UQ;
            if (r < I_UKV) { const int kb = r / 32, nb = r % 32;
                cvt_item(a.in(8) + (size_t)l * 256 * 2048, 2048, kb * 64, nb * 64, (bf16*)(wl + W_UKV), nb * 64, 256, scr, F.lane); continue; } r -= I_UKV;
            if (r < I_O) { const int kb = r / 32, nb = r % 32;
                cvt_item(a.in(15) + (size_t)l * DM * DM, DM, kb * 64, nb * 64, (bf16*)(wl + W_O), nb * 64, DM, scr, F.lane); continue; } r -= I_O;
            cvt_item(a.in(18) + (size_t)l * DM * 64, 64, r * 64, 0, (bf16*)(wl + W_R), 0, DM, scr, F.lane);
        }
        for (int l = 0; l < NLAYER; ++l) { u32x4* z = (u32x4*)(ws + WS_W + (size_t)l * W_LSTRIDE + W_IN + (size_t)832 * DM * 2);
            for (int i = blockIdx.x * 512 + F.tid; i < 192 * DM * 2 / 16; i += F.G * 512) z[i] = (u32x4){0u, 0u, 0u, 0u}; }
    }
}

__device__ __forceinline__ void ln_mod_row(const float* xrow, const float* sh, const float* sc, bf16* hrow, int lane) {
    f32x4 v[8];
#pragma unroll
    for (int j = 0; j < 8; ++j) v[j] = *(const f32x4*)(xrow + 4 * lane + 256 * j);
    float mean, rstd; row_stats(v, mean, rstd);
#pragma unroll
    for (int j = 0; j < 8; ++j) { const f32x4 s1 = *(const f32x4*)(sc + 4 * lane + 256 * j) + 1.0f, s0 = *(const f32x4*)(sh + 4 * lane + 256 * j);
        const f32x4 y = (v[j] - mean) * rstd * s1 + s0;
        u32x2 w; w.x = cvt_pk_bf16(y.x, y.y); w.y = cvt_pk_bf16(y.z, y.w); *(u32x2*)(hrow + 4 * lane + 256 * j) = w; }
}

__device__ __forceinline__ void post_u_row(bf16* urow, int pos, const float* gq, const float* gkv, const f32x2* ropeM, const f32x2* ropeD, int lane) {
    u32x4 wq = *(u32x4*)(urow + U_CQ + 8 * lane);
    u32x2 wk = *(u32x2*)(urow + U_CKV + 4 * lane);
    const int lr = lane & 31;
    const unsigned short kra = *(const unsigned short*)(urow + U_KR + lr), krc = *(const unsigned short*)(urow + U_KR + 32 + lr);
    const f32x2 csk = ropeM[(size_t)pos * 32 + lr];
    unsigned short da[2], dc[2]; f32x2 csd[2];
#pragma unroll
    for (int t = 0; t < 2; ++t) { const int pi = lane + 64 * t, blk = pi >> 3, j = pi & 7; const bf16* p = urow + U_DF + blk * 64 + j;
        da[t] = *(const unsigned short*)(p); dc[t] = *(const unsigned short*)(p + 8); csd[t] = ropeD[(size_t)pos * 8 + j]; }
    const f32x4 g0 = *(const f32x4*)(gq + 8 * lane), g1 = *(const f32x4*)(gq + 8 * lane + 4), gk = *(const f32x4*)(gkv + 4 * lane);
    asm volatile("" ::: "memory");
    {
        float x[8] = {bflo(wq.x), bfhi(wq.x), bflo(wq.y), bfhi(wq.y), bflo(wq.z), bfhi(wq.z), bflo(wq.w), bfhi(wq.w)};
        float ss = 0.f;
#pragma unroll
        for (int i = 0; i < 8; ++i) ss += x[i] * x[i];
        const float rs = rsqrtf(wave_sum(ss) * (1.f / 512.f) + RMS_EPS);
        wq.x = cvt_pk_bf16(x[0] * rs * g0.x, x[1] * rs * g0.y); wq.y = cvt_pk_bf16(x[2] * rs * g0.z, x[3] * rs * g0.w);
        wq.z = cvt_pk_bf16(x[4] * rs * g1.x, x[5] * rs * g1.y); wq.w = cvt_pk_bf16(x[6] * rs * g1.z, x[7] * rs * g1.w);
    }
    {
        float x[4] = {bflo(wk.x), bfhi(wk.x), bflo(wk.y), bfhi(wk.y)};
        const float ss = x[0] * x[0] + x[1] * x[1] + x[2] * x[2] + x[3] * x[3];
        const float rs = rsqrtf(wave_sum(ss) * (1.f / 256.f) + RMS_EPS);
        wk.x = cvt_pk_bf16(x[0] * rs * gk.x, x[1] * rs * gk.y); wk.y = cvt_pk_bf16(x[2] * rs * gk.z, x[3] * rs * gk.w);
    }
    *(u32x4*)(urow + U_CQ + 8 * lane) = wq;
    *(u32x2*)(urow + U_CKV + 4 * lane) = wk;
    if (lane < 32) {
        const float a = bf2f(kra), c = bf2f(krc);
        urow[U_KR + lane] = (bf16)(cvt_pk_bf16(a * csk.x - c * csk.y, 0.f) & 0xffffu);
        urow[U_KR + 32 + lane] = (bf16)(cvt_pk_bf16(c * csk.x + a * csk.y, 0.f) & 0xffffu);
    }
#pragma unroll
    for (int t = 0; t < 2; ++t) {
        const int pi = lane + 64 * t, blk = pi >> 3, j = pi & 7;
        bf16* p = urow + U_DF + blk * 64 + j;
        const float a = bf2f(da[t]), c = bf2f(dc[t]);
        p[0] = (bf16)(cvt_pk_bf16(a * csd[t].x - c * csd[t].y, 0.f) & 0xffffu);
        p[8] = (bf16)(cvt_pk_bf16(c * csd[t].x + a * csd[t].y, 0.f) & 0xffffu);
    }
}

__device__ __forceinline__ void diff_combine_row(const float* o1, const float* o2, bf16* mrow, float lam, const float* subln, float omli, int lane) {
    const f32x2 g = *(const f32x2*)(subln + 2 * lane);
    f32x2 av[4], cv[4];
#pragma unroll
    for (int h = 0; h < 4; ++h) { av[h] = __builtin_nontemporal_load((const f32x2*)(o1 + h * 128 + 2 * lane)); cv[h] = __builtin_nontemporal_load((const f32x2*)(o2 + h * 128 + 2 * lane)); }
    asm volatile("" ::: "memory");
#pragma unroll
    for (int h = 0; h < 4; ++h) {
        const f32x2 a = av[h], c = cv[h];
        const f32x2 d = a - c * lam;
        const float rs = rsqrtf(wave_sum(d.x * d.x + d.y * d.y) * (1.f / 128.f) + RMS_EPS);
        *(unsigned*)(mrow + 1536 + h * 128 + 2 * lane) = cvt_pk_bf16(d.x * rs * g.x * omli, d.y * rs * g.y * omli);
    }
}

__device__ __forceinline__ void p6_tile(Frame& F, const KA& a, int l, int tile) {
    unsigned char* ws = a.ws();
    constexpr int HS = 4112;
    LAS unsigned char* hT = F.lds; LAS float* LG = (LAS float*)(F.lds + 132096);
    const float* Y = (const float*)(ws + WS_Y); float* X1 = (float*)(ws + WS_X1); bf16* H = (bf16*)(ws + WS_H);
    const float* g1 = a.in(16) + (size_t)l * DM; const float* b1 = a.in(17) + (size_t)l * DM;
    const int row0 = tile * 32; const int b = row0 >> 12;
    const float* ada = (const float*)(ws + WS_ADA) + (size_t)(l * 2 + b) * ADA_W;
    const float* shf = ada + 3 * DM; const float* scf = ada + 4 * DM;
    f32x4 vn[8];
#pragma unroll
    for (int j = 0; j < 8; ++j) vn[j] = __builtin_nontemporal_load((const f32x4*)(Y + (size_t)(row0 + F.wave * 4) * DM + 4 * F.lane + 256 * j));
#pragma unroll 1
    for (int rr = 0; rr < 4; ++rr) {
        const int lr = F.wave * 4 + rr, row = row0 + lr;
        f32x4 v[8];
#pragma unroll
        for (int j = 0; j < 8; ++j) v[j] = vn[j];
        if (rr < 3) {
#pragma unroll
            for (int j = 0; j < 8; ++j) vn[j] = __builtin_nontemporal_load((const f32x4*)(Y + (size_t)(row + 1) * DM + 4 * F.lane + 256 * j));
        }
        float mean, rstd; row_stats(v, mean, rstd);
#pragma unroll
        for (int j = 0; j < 8; ++j) { const f32x4 g = *(const f32x4*)(g1 + 4 * F.lane + 256 * j), bb = *(const f32x4*)(b1 + 4 * F.lane + 256 * j);
            v[j] = (v[j] - mean) * rstd * g + bb; __builtin_nontemporal_store(v[j], (f32x4*)(X1 + (size_t)row * DM + 4 * F.lane + 256 * j)); }
        row_stats(v, mean, rstd);
#pragma unroll
        for (int j = 0; j < 8; ++j) { const f32x4 s1 = *(const f32x4*)(scf + 4 * F.lane + 256 * j) + 1.0f, s0 = *(const f32x4*)(shf + 4 * F.lane + 256 * j);
            const f32x4 y = (v[j] - mean) * rstd * s1 + s0;
            u32x2 w; w.x = cvt_pk_bf16(y.x, y.y); w.y = cvt_pk_bf16(y.z, y.w);
            if (MOE_FP8_LAST && (MOE_FP8_GU_ALL || l == NLAYER - 1)) { int q8 = __builtin_amdgcn_cvt_pk_fp8_f32(clamp8(y.x), clamp8(y.y), 0, false); q8 = __builtin_amdgcn_cvt_pk_fp8_f32(clamp8(y.z), clamp8(y.w), q8, true);
                *(int*)((unsigned char*)H + (size_t)row * DM + 4 * F.lane + 256 * j) = q8; }
            else *(u32x2*)(H + (size_t)row * DM + 4 * F.lane + 256 * j) = w;
            *(LAS u32x2*)(hT + lr * HS + (4 * F.lane + 256 * j) * 2) = w; }
    }
    __syncthreads();
    {
        const int mt = F.wave >> 2, nt = F.wave & 3, fr = F.lane & 15, fq = F.lane >> 4;
        const bf16* Wr = (const bf16*)(ws + WS_W + (size_t)l * W_LSTRIDE + W_R) + (size_t)(nt * 16 + fr) * DM + fq * 8;
        const LAS unsigned char* ap = hT + (mt * 16 + fr) * HS + fq * 16;
        f32x4 acc = {0.f, 0.f, 0.f, 0.f};
#pragma unroll 8
        for (int ks = 0; ks < 64; ++ks) { const bf16x8 av = *(const LAS bf16x8*)(ap + ks * 64); const bf16x8 bv = *(const bf16x8*)(Wr + ks * 32);
            acc = __builtin_amdgcn_mfma_f32_16x16x32_bf16(av, bv, acc, 0, 0, 0); }
#pragma unroll
        for (int i = 0; i < 4; ++i) LG[(mt * 16 + fq * 4 + i) * 64 + nt * 16 + fr] = acc[i];
    }
    LAS unsigned* lc = (LAS unsigned*)(F.lds + 140288); LAS unsigned* gb = lc + 64;
    if (F.tid < 64) lc[F.tid] = 0u;
    __syncthreads();
    {
        const float bias = a.in(19)[(size_t)l * 64 + F.lane];
        unsigned* cnt = (unsigned*)(ws + WS_CTL) + CW_CNT + l * 4096;
        int* list = (int*)(ws + WS_LIST); int* tokslot = (int*)(ws + WS_TOKSLOT); float* tokw = (float*)(ws + WS_TOKW);
        int rk[4]; float wq[4]; unsigned ps[4];
#pragma unroll
        for (int rr = 0; rr < 4; ++rr) {
            const int lr = F.wave * 4 + rr;
            const float lg = LG[lr * 64 + F.lane];
            const float sg = 1.f / (1.f + __expf(-lg));
            const float bs = sg + bias;
            float m1 = bs;
#pragma unroll
            for (int o = 1; o < 8; o <<= 1) m1 = fmaxf(m1, shfl_idx(m1, F.lane ^ o));
            const unsigned long long eq = __ballot(bs == m1);
            const int gbase = F.lane & ~7;
            const unsigned gm = (unsigned)((eq >> gbase) & 0xffull);
            const int first = gbase + __builtin_ctz(gm);
            float m2 = (F.lane == first) ? -__builtin_huge_valf() : bs;
#pragma unroll
            for (int o = 1; o < 8; o <<= 1) m2 = fmaxf(m2, shfl_idx(m2, F.lane ^ o));
            const float gs = m1 + m2; const int g = F.lane >> 3;
            int grank = 0;
#pragma unroll
            for (int q = 0; q < 8; ++q) { const float og = shfl_idx(gs, q * 8); grank += (og > gs || (og == gs && q < g)) ? 1 : 0; }
            const float val = (grank < 4) ? bs : -__builtin_huge_valf();
            int rank = 0;
#pragma unroll 8
            for (int q = 0; q < 64; ++q) { const float ov = shfl_idx(val, q); rank += (ov > val || (ov == val && q < F.lane)) ? 1 : 0; }
            const bool sel = rank < 8;
            const float wsum = wave_sum(sel ? sg : 0.f);
            rk[rr] = sel ? rank : -1; wq[rr] = sg / wsum * 2.5f;
        }
#pragma unroll
        for (int rr = 0; rr < 4; ++rr) ps[rr] = (rk[rr] >= 0) ? __hip_atomic_fetch_add(&lc[F.lane], 1u, __ATOMIC_RELAXED, __HIP_MEMORY_SCOPE_WORKGROUP) : 0u;
        __syncthreads();
        if (F.wave == 0) { const unsigned n = lc[F.lane]; gb[F.lane] = n ? atomicAdd(cnt + 64 * F.lane, n) : 0u; }
        __syncthreads();
        const unsigned gbase = gb[F.lane];
#pragma unroll
        for (int rr = 0; rr < 4; ++rr) ps[rr] += gbase;
#pragma unroll
        for (int rr = 0; rr < 4; ++rr) if (rk[rr] >= 0) { const int tok = row0 + F.wave * 4 + rr;
            list[F.lane * 8192 + ps[rr]] = tok;
            tokslot[tok * 8 + rk[rr]] = (F.lane << 16) | (int)ps[rr];
            tokw[tok * 8 + rk[rr]] = wq[rr]; }
    }
    __syncthreads();
}

__device__ __forceinline__ void moe_tables(Frame& F, const KA& a, int l, LAS int* pref, LAS int* cntL) {
    const unsigned* cnt = (const unsigned*)(a.ws() + WS_CTL) + CW_CNT + l * 4096;
    if (F.tid < 64) cntL[F.tid] = (int)__hip_atomic_load(cnt + 64 * F.tid, RLX_AGENT);
    if (F.tid == 64) cntL[64] = NTOK;
    __syncthreads();
    if (F.tid < 64) {
        const int nt_e = (cntL[F.tid] + 255) >> 8; int inc = nt_e;
#pragma unroll
        for (int o = 1; o < 64; o <<= 1) { const int up = __builtin_amdgcn_ds_bpermute(((F.tid - o) & 63) << 2, inc); if (F.tid >= o) inc += up; }
        pref[F.tid] = inc - nt_e;
        if (F.tid == 63) { pref[64] = inc; pref[NE1] = inc + (NTOK >> 8); }
    }
    __syncthreads();
    if (F.tid < NE1) { const int t0 = pref[F.tid], t1 = pref[F.tid + 1]; for (int t = t0; t < t1; ++t) pref[400 + t] = F.tid; }
    __syncthreads();
}

__device__ __forceinline__ void p9_row(const KA& a, int l, int row, const LAS int* pref, int lane, int ts_l, float w_l) {
    unsigned char* ws = a.ws();
    const unsigned char* YS = ws + WS_YS; const float* X1 = (const float*)(ws + WS_X1);
    const int b = row >> 12;
    const float* ada = (const float*)(ws + WS_ADA) + (size_t)(l * 2 + b) * ADA_W;
    const float* gf = ada + 5 * DM;
    f32x4 m[8];
#pragma unroll
    for (int j = 0; j < 8; ++j) m[j] = (f32x4){0.f, 0.f, 0.f, 0.f};
    int slot_l = (lane < 8) ? pref[ts_l >> 16] * 256 + (ts_l & 0xffff) : pref[64] * 256 + row;
    if (lane >= 8) w_l = 1.f;
    w_l *= (1.f / YS_SCALE);
    const __amdgpu_buffer_rsrc_t yrs = __builtin_amdgcn_make_buffer_rsrc((void*)YS, 0, (unsigned)((size_t)SLOT_MAX * DM), 0x00020000);
    const int voff = 4 * lane;
    int yv[8][8], ys[8];
#pragma unroll
    for (int k = 0; k < 8; ++k) { const int soff = __builtin_amdgcn_readlane(slot_l, k) * DM;
#pragma unroll
        for (int j = 0; j < 8; ++j) yv[k][j] = __builtin_amdgcn_raw_buffer_load_b32(yrs, voff + 256 * j, soff, 2); }
#pragma unroll
    for (int k = 0; k < 8; ++k) { const float w = __builtin_bit_cast(float, __builtin_amdgcn_readlane(__builtin_bit_cast(int, w_l), k));
        if (k == 0) { const int soff = __builtin_amdgcn_readlane(slot_l, 8) * DM;
#pragma unroll
            for (int j = 0; j < 8; ++j) ys[j] = __builtin_amdgcn_raw_buffer_load_b32(yrs, voff + 256 * j, soff, 2); }
#pragma unroll
        for (int j = 0; j < 8; ++j) { const f32x2 lo = __builtin_amdgcn_cvt_pk_f32_fp8(yv[k][j], false), hi = __builtin_amdgcn_cvt_pk_f32_fp8(yv[k][j], true);
            m[j].x = fmaf(w, lo.x, m[j].x); m[j].y = fmaf(w, lo.y, m[j].y); m[j].z = fmaf(w, hi.x, m[j].z); m[j].w = fmaf(w, hi.y, m[j].w); } }
    { const float w = 1.f / YS_SCALE;
#pragma unroll
        for (int j = 0; j < 8; ++j) { const f32x2 lo = __builtin_amdgcn_cvt_pk_f32_fp8(ys[j], false), hi = __builtin_amdgcn_cvt_pk_f32_fp8(ys[j], true);
            m[j].x = fmaf(w, lo.x, m[j].x); m[j].y = fmaf(w, lo.y, m[j].y); m[j].z = fmaf(w, hi.x, m[j].z); m[j].w = fmaf(w, hi.y, m[j].w); } }
    asm volatile("" ::: "memory");
    f32x4 v[8];
#pragma unroll
    for (int j = 0; j < 8; ++j) { const f32x4 x1 = __builtin_nontemporal_load((const f32x4*)(X1 + (size_t)row * DM + 4 * lane + 256 * j)), g = *(const f32x4*)(gf + 4 * lane + 256 * j) + 1.0f;
        v[j] = x1 * DN_ALPHA + g * m[j]; }
    float mean, rstd; row_stats(v, mean, rstd);
    const float* g2 = a.in(26) + (size_t)l * DM; const float* b2 = a.in(27) + (size_t)l * DM;
    asm volatile("" ::: "memory");
#pragma unroll
    for (int j = 0; j < 8; ++j) { const f32x4 g = *(const f32x4*)(g2 + 4 * lane + 256 * j), bb = *(const f32x4*)(b2 + 4 * lane + 256 * j);
        v[j] = (v[j] - mean) * rstd * g + bb; *(f32x4*)(a.out() + (size_t)row * DM + 4 * lane + 256 * j) = v[j]; }
    asm volatile("" ::: "memory");
    if (l + 1 < NLAYER) {
        const float* ada2 = (const float*)(ws + WS_ADA) + (size_t)((l + 1) * 2 + b) * ADA_W;
        row_stats(v, mean, rstd);
        bf16* hrow = (bf16*)(ws + WS_H) + (size_t)row * DM;
#pragma unroll
        for (int j = 0; j < 8; ++j) { const f32x4 s1 = *(const f32x4*)(ada2 + DM + 4 * lane + 256 * j) + 1.0f, s0 = *(const f32x4*)(ada2 + 4 * lane + 256 * j);
            const f32x4 y = (v[j] - mean) * rstd * s1 + s0;
            u32x2 w; w.x = cvt_pk_bf16(y.x, y.y); w.y = cvt_pk_bf16(y.z, y.w); *(u32x2*)(hrow + 4 * lane + 256 * j) = w; }
    }
}

__device__ __forceinline__ Frame make_frame(unsigned char* ws) {
    extern __shared__ __attribute__((aligned(16))) unsigned char lds_raw[];
    Frame F;
    F.lds = (LAS unsigned char*)lds_raw;
    F.MISC = (volatile LAS unsigned*)(F.lds + MISC_OFF);
    int t = tid_x(); asm volatile("" : "+v"(t));
    F.tid = t; F.lane = t & 63; F.wave = __builtin_amdgcn_readfirstlane(t >> 6);
    F.G = gridDim.x; F.gw = blockIdx.x * 8 + F.wave; F.NGW = F.G * 8;
    F.ctl = (unsigned*)(ws + WS_CTL);
    return F;
}

__global__ void __launch_bounds__(512, 2) mk_fwd(Args args) {
    extern __shared__ __attribute__((aligned(16))) unsigned char lds_raw[];
    XcdBarrier bar;
    int lo, hi;
    {
        const KA a = fresh_ka(); unsigned char* ws = a.ws();
        LAS unsigned char* lds = (LAS unsigned char*)lds_raw;
        for (int u = threadIdx.x; u < 128; u += 512) ((LAS unsigned*)(lds + MISC_OFF))[u] = 0u;
        __syncthreads();
        if ((threadIdx.x & 63) == 0) ((LAS int*)(lds + MISC_OFF))[64 + hw_wave_slot()] = (int)(threadIdx.x >> 6);
        __syncthreads();
        unsigned* ctl = (unsigned*)(ws + WS_CTL);
        bar.bar = ctl + CW_BAR; bar.x = 0; bar.st = (volatile LAS unsigned*)(lds + MISC_OFF) + 8;
        if (!MK_PER_PHASE) bar = xcd_barrier_post(ctl + CW_BAR, (volatile LAS unsigned*)(lds + MISC_OFF) + 8);
        lo = a.ph_lo(); hi = a.ph_hi();
    }
#ifndef PHMASK
#define PHMASK 0xFFFFu
#endif
#define PT(t) (((PHMASK) >> (t)) & 1u)
#define IN(k) (lo <= (k) && (k) < hi)
#define SEAM(k) do { if (!MK_PER_PHASE && (k) + 1 < hi) xcd_barrier_work(bar, a, ws, F.lds); } while (0)
#define PHASE_BEGIN() const KA a = fresh_ka(); unsigned char* ws = a.ws(); Frame F = make_frame(ws); (void)F

    if (PT(0) && IN(0)) { PHASE_BEGIN(); p0_prologue(F, a); SEAM(0); }
    if (PT(1) && IN(1)) {
        PHASE_BEGIN();
        const float* ADA = (const float*)(ws + WS_ADA); bf16* H = (bf16*)(ws + WS_H); const float* x = a.in(0);
        for (int row = F.gw; row < NTOK; row += F.NGW) { const float* ada = ADA + (size_t)(row >> 12) * ADA_W;
            ln_mod_row(x + (size_t)row * DM, ada, ada + DM, H + (size_t)row * DM, F.lane); }
        SEAM(1);
    }
#pragma unroll 1
    for (int l = 0; l < NLAYER; ++l) {
        const int pb = 2 + 8 * l;
        if (PT(2) && IN(pb + 0)) {
            PHASE_BEGIN(); unsigned char* wl = ws + WS_W + (size_t)l * W_LSTRIDE;
            pg8::DenseSched S; S.init(ws + WS_H, DM, wl + W_IN, NTOK, UW, DM, F.G, (int)blockIdx.x);
            pg8::EpiBf16 E{(bf16*)(ws + WS_U), UW};
            pg8::gemm_phase<GEMM_SP2, true>(F.lds, S, E, DM);
            SEAM(pb + 0);
        }
        if (PT(3) && IN(pb + 1)) {
            PHASE_BEGIN(); bf16* U = (bf16*)(ws + WS_U);
            const float* gq = a.in(5) + (size_t)l * 512; const float* gkv = a.in(7) + (size_t)l * 256;
            for (int row = F.gw; row < NTOK; row += F.NGW)
                post_u_row(U + (size_t)row * UW, row & (SEQ - 1), gq, gkv, (const f32x2*)(ws + WS_ROPEM), (const f32x2*)(ws + WS_ROPED), F.lane);
            SEAM(pb + 1);
        }
        if (PT(4) && IN(pb + 2)) {
            PHASE_BEGIN(); unsigned char* wl = ws + WS_W + (size_t)l * W_LSTRIDE; bf16* U = (bf16*)(ws + WS_U);
            const bool has_na = (((int)blockIdx.x >> 3) & 1) == 0 || F.G != 256;
            { pg8::DenseSched S;
              if (F.G == 256) S.init(U + U_CQ, UW, wl + W_UQ, NTOK, QMW, 512, 128, has_na ? (1 << 20) : (int)((blockIdx.x & 7) + 8 * (blockIdx.x >> 4)));
              else S.init(U + U_CQ, UW, wl + W_UQ, NTOK, QMW, 512, F.G, (int)blockIdx.x);
              pg8::EpiBf16 E{(bf16*)(ws + WS_QM), QMW}; pg8::gemm_phase<GEMM_SP2, false>(F.lds, S, E, 512); }
            { pg8::DenseSched S; S.init(U + U_CKV, UW, wl + W_UKV, NTOK, KVW, 256, F.G, (int)blockIdx.x);
              pg8::EpiBf16 E{(bf16*)(ws + WS_KVM), KVW}; pg8::gemm_phase<GEMM_SP2, false>(F.lds, S, E, 256); }
            {
                att::AttnP P; P.U = (const bf16*)(ws + WS_U); P.QM = (const bf16*)(ws + WS_QM); P.KVM = (const bf16*)(ws + WS_KVM); P.MIX = (bf16*)(ws + WS_MIX);
                P.O1 = (float*)(ws + WS_O1); P.O2 = (float*)(ws + WS_O2); P.ropeM = (const f32x2*)(ws + WS_ROPEM); P.rpb = a.in(9) + (size_t)l * 4 * 465;
                LAS char* al = (LAS char*)F.lds;
                for (int c = blockIdx.x; c < 256; c += F.G) {
                    const int xcd = c & 7, j = c >> 3;
                    const int du = (xcd * 16 + (j & 15));
                    if (j >> 4) att::attn_unit<att::MODE_DIFF, 1>(P, du, al); else att::attn_unit<att::MODE_DIFF, 0>(P, du, al);
                    if (!(j & 1)) att::attn_unit<att::MODE_NA>(P, xcd * 16 + (j >> 1), al);
                }
            }
            SEAM(pb + 2);
        }
        if (PT(5) && IN(pb + 3)) {
            PHASE_BEGIN();
            att::AttnP P; P.U = (const bf16*)(ws + WS_U); P.QM = (const bf16*)(ws + WS_QM); P.KVM = (const bf16*)(ws + WS_KVM); P.MIX = (bf16*)(ws + WS_MIX);
            P.O1 = (float*)(ws + WS_O1); P.O2 = (float*)(ws + WS_O2); P.ropeM = (const f32x2*)(ws + WS_ROPEM);
            P.rpb = a.in(9) + (size_t)l * 4 * 465;
            LAS char* al = (LAS char*)F.lds;
#ifndef ATT_MASK
#define ATT_MASK 7
#endif
            {
                const float lam_init = (l == 0) ? 0.2f : 0.35550906759096934f;
                const float la = a.in(10)[l * 64 + F.lane] * a.in(11)[l * 64 + F.lane], lb = a.in(12)[l * 64 + F.lane] * a.in(13)[l * 64 + F.lane];
                const float lam = __expf(wave_sum(la)) - __expf(wave_sum(lb)) + lam_init;
                const float* o1 = (const float*)(ws + WS_O1); const float* o2 = (const float*)(ws + WS_O2); bf16* MIXp = (bf16*)(ws + WS_MIX);
                for (int row = F.gw; row < NTOK; row += F.NGW)
                    diff_combine_row(o1 + (size_t)row * 512, o2 + (size_t)row * 512, MIXp + (size_t)row * DM, lam, a.in(14) + l * 128, 1.0f - lam_init, F.lane);
                __syncthreads();
            }
            const bool conv_first = ((blockIdx.x >> 3) & 1) != 0;
            if (conv_first) conv_drain(a, ws, F.lds, (l + 1) * Q_PER_L, CONV_QUOTA);
            for (int c = blockIdx.x; c < 256; c += F.G) {
                const int xcd = c & 7, j = c >> 3;
                if (ATT_MASK & 1) att::attn_unit<att::MODE_MLA>(P, (xcd * 2 + (j >> 4)) * 16 + (j & 15), al);
            }
            if (!conv_first) conv_drain(a, ws, F.lds, (l + 1) * Q_PER_L, CONV_QUOTA);
            SEAM(pb + 3);
        }
        if (PT(6) && IN(pb + 4)) {
            PHASE_BEGIN(); unsigned char* wl = ws + WS_W + (size_t)l * W_LSTRIDE;
            const float* xin = (l == 0) ? a.in(0) : (const float*)a.out();
            pg8::DenseSched S; S.init(ws + WS_MIX, DM, wl + W_O, NTOK, DM, DM, F.G, (int)blockIdx.x);
            pg8::EpiResid E{xin, (const float*)(ws + WS_ADA) + (size_t)(l * 2) * ADA_W + 2 * DM, (float*)(ws + WS_Y)};
            pg8::gemm_phase<GEMM_SP2, false>(F.lds, S, E, DM);
            SEAM(pb + 4);
        }
        if (PT(7) && IN(pb + 5)) {
            PHASE_BEGIN();
            for (int t = blockIdx.x; t < NTOK / 32; t += F.G) p6_tile(F, a, l, t);
            conv_drain(a, ws, F.lds, (l + 1) * Q_PER_L);
            SEAM(pb + 5);
        }
        if (PT(8) && IN(pb + 6)) {
            PHASE_BEGIN(); unsigned char* wl = ws + WS_W + (size_t)l * W_LSTRIDE;
            LAS int* pref = (LAS int*)(F.lds + EXTRA_OFF); LAS int* cntL = pref + 80;
            moe_tables(F, a, l, pref, cntL);
            unsigned* ready = F.ctl + CW_MT + l * 32768;
            const int tgu = pref[NE1] * 4;
            const int moe_c = (MOE_CHUNK && (F.G & 7) == 0) ? (int)((blockIdx.x & 7u) * (unsigned)(F.G >> 3) + (blockIdx.x >> 3)) : (int)blockIdx.x;
            const bool f8 = MOE_FP8_LAST && (MOE_FP8_GU_ALL || l == NLAYER - 1);
            const bool f8d = f8 || (MOE_FP8_LAST && MOE_FP8_DOWN_ALL);
            {
                pg8::MoeGUSched S; S.Hb = (const char*)(ws + WS_H); S.W = (const char*)(wl + W_GU); S.list = (const int*)(ws + WS_LIST); S.pref = pref; S.cnt = cntL;
                S.total = tgu; S.G = F.G; S.c = moe_c; S.rowB = f8 ? DM : DM * 2;
                if (f8) { pg8::EpiGateUpT<true> E{(bf16*)(ws + WS_ACT), ready}; pg8::gemm_phase<GEMM_SP2, true, true>(F.lds, S, E, DM / 2, 121, 127); }
                else if (f8d) { pg8::EpiGateUpT<true> E{(bf16*)(ws + WS_ACT), ready}; pg8::gemm_phase<GEMM_SP2, true>(F.lds, S, E, DM); }
                else { pg8::EpiGateUp E{(bf16*)(ws + WS_ACT), ready}; pg8::gemm_phase<GEMM_SP2, true>(F.lds, S, E, DM); }
            }
            {
                pg8::MoeDownSched S; S.Act = (const char*)(ws + WS_ACT); S.W = (const char*)(wl + W_D); S.pref = pref; S.total = pref[NE1] * 8; S.G = F.G;
                const int n6r = tgu % F.G; S.c = (int)((moe_c + F.G - n6r) % F.G);
                if (DOWN_LEAD > 0 && n6r > 0) { S.n6 = n6r; S.lead = (moe_c >= n6r) ? 1 : 0; }
                else { S.n6 = F.G; S.lead = 0; }
                S.ready = ready; S.tmo = F.ctl + CW_TMO; S.rowB = f8d ? FFE : FFE * 2;
                pg8::EpiFp8 E{ws + WS_YS, DM, YS_SCALE};
                if (f8d) pg8::gemm_phase<GEMM_SP2, true, true>(F.lds, S, E, FFE / 2, 121, 125);
                else pg8::gemm_phase<GEMM_SP2, true>(F.lds, S, E, FFE);
            }
            SEAM(pb + 6);
        }
        if (PT(10) && IN(pb + 7)) {
            PHASE_BEGIN();
            LAS int* pref = (LAS int*)(F.lds + EXTRA_OFF); LAS int* cntL = pref + 80;
            moe_tables(F, a, l, pref, cntL);
            {
                const int* tokslot = (const int*)(ws + WS_TOKSLOT); const float* tokw = (const float*)(ws + WS_TOKW);
                int t = 0; float w = 0.f;
                if (F.lane < 8 && F.gw < NTOK) { t = tokslot[F.gw * 8 + F.lane]; w = tokw[F.gw * 8 + F.lane]; }
#pragma unroll 1
                for (int row = F.gw; row < NTOK; row += F.NGW) { int tn = 0; float wn = 0.f; const int nr = row + F.NGW;
                    if (F.lane < 8 && nr < NTOK) { tn = tokslot[nr * 8 + F.lane]; wn = tokw[nr * 8 + F.lane]; }
                    p9_row(a, l, row, pref, F.lane, t, w); t = tn; w = wn; }
            }
            SEAM(pb + 7);
        }
    }
#undef IN
#undef SEAM
}

extern "C" void kernel_launch(void* const* d_in, const int* in_sizes, int n_in, void* d_out, int out_size, void* d_ws, size_t ws_size, hipStream_t stream) {
    static int grid = 0;
    if (grid == 0) {
        if (n_in != 28 || out_size != NTOK * DM || ws_size < WS_END) { fprintf(stderr, "kernel_launch: unexpected shapes: n_in %d out %d ws %zu (need %zu)\n", n_in, out_size, ws_size, (size_t)WS_END); grid = -1; return; }
        int dev = 0, cus = 0, per_cu = 0;
        if (hipGetDevice(&dev) != hipSuccess || hipDeviceGetAttribute(&cus, hipDeviceAttributeMultiprocessorCount, dev) != hipSuccess) { grid = -1; return; }
        if (hipFuncSetAttribute((const void*)mk_fwd, hipFuncAttributeMaxDynamicSharedMemorySize, LDS_BYTES) != hipSuccess) { fprintf(stderr, "kernel_launch: hipFuncSetAttribute failed\n"); grid = -1; return; }
        if (hipOccupancyMaxActiveBlocksPerMultiprocessor(&per_cu, (const void*)mk_fwd, 512, LDS_BYTES) != hipSuccess || per_cu < 1) { fprintf(stderr, "kernel_launch: occupancy query says %d\n", per_cu); }
        (void)hipGetLastError();
        grid = cus;
    }
    if (grid < 0) return;
    (void)hipMemsetAsync((char*)d_ws + WS_CTL, 0, CTL_ZERO_BYTES, stream);
    Args a{};
    for (int i = 0; i < 28; ++i) a.in[i] = (const float*)d_in[i];
    a.out = (float*)d_out; a.ws = (unsigned char*)d_ws;
#if MK_PER_PHASE
    for (int p = 0; p < NPHASE; ++p) { a.ph_lo = p; a.ph_hi = p + 1; hipLaunchKernelGGL(mk_fwd, dim3(grid), dim3(512), LDS_BYTES, stream, a); }
#else
    a.ph_lo = 0; a.ph_hi = NPHASE;
    hipLaunchKernelGGL(mk_fwd, dim3(grid), dim3(512), LDS_BYTES, stream, a);
#endif
    const hipError_t le = hipPeekAtLastError();
    if (le != hipSuccess) fprintf(stderr, "kernel_launch: launch failed: %s\n", hipGetErrorName(le));
}
```
